# Optimizing an MI355X kernel written in HIP

```python
import math
import jax, jax.numpy as jnp
from jax import lax
import numpy as np

D_MODEL = 1024
BATCH = 1
SEQ = 16384
DEPTH = 4

N_MIXERS = 4
EPS = 1e-6
NEG = -1e30
MLSTM_HEADS = 4
MLSTM_DQK = 128
MLSTM_DV = D_MODEL // MLSTM_HEADS
MLSTM_CHUNK = 128
MLSTM_IN = 2 * MLSTM_HEADS * MLSTM_DQK + 2 * MLSTM_HEADS * MLSTM_DV + 2 * MLSTM_HEADS
ATTN_HEADS = 16
ATTN_DH = D_MODEL // ATTN_HEADS
ROPE_DIMS = ATTN_DH // 4
ROPE_THETA = 500000.0
MOBA_BLOCK = 256
MOBA_TOPK = 3
Q_BLOCK = 128
CONV_WIDTH = 3
FFN_HIDDEN = -(-(8 * D_MODEL) // (3 * 256)) * 256

kernel_name = "hybrid_mlstm_moba_shortconv_stickbreak"


def rms_norm(x, g):
    xf = x.astype(jnp.float32)
    y = xf * lax.rsqrt(jnp.mean(xf * xf, axis=-1, keepdims=True) + EPS)
    return (y * g.astype(jnp.float32)).astype(x.dtype)


def partial_rope(x, positions):
    half = ROPE_DIMS // 2
    inv = ROPE_THETA ** (-jnp.arange(half, dtype=jnp.float32) / half)
    ang = positions.astype(jnp.float32)[..., None] * inv
    cos = jnp.cos(ang)[:, :, None, :]
    sin = jnp.sin(ang)[:, :, None, :]
    xr = x[..., :ROPE_DIMS].astype(jnp.float32)
    x1, x2 = xr[..., :half], xr[..., half:]
    rot = jnp.concatenate([x1 * cos - x2 * sin, x2 * cos + x1 * sin], axis=-1).astype(x.dtype)
    return jnp.concatenate([rot, x[..., ROPE_DIMS:]], axis=-1)


def mlstm_mixer(h, w_in, b_gate, head_gain, w_out):
    B, S, _ = h.shape
    NH, DK, DV, L = MLSTM_HEADS, MLSTM_DQK, MLSTM_DV, MLSTM_CHUNK
    nc = S // L
    proj = h @ w_in
    q, k, v, o_pre, g_pre = jnp.split(
        proj, [NH * DK, 2 * NH * DK, 2 * NH * DK + NH * DV, 2 * NH * DK + 2 * NH * DV], axis=-1)
    g = g_pre.astype(jnp.float32) + b_gate.astype(jnp.float32)
    i_log = g[..., :NH]
    f_log = jax.nn.log_sigmoid(g[..., NH:])

    def to_chunks(t, d):
        return t.astype(jnp.float32).reshape(B, nc, L, NH, d).transpose(1, 0, 3, 2, 4)

    def gate_chunks(t):
        return t.reshape(B, nc, L, NH).transpose(1, 0, 3, 2)

    qc = to_chunks(q, DK) * (DK ** -0.5)
    kc = to_chunks(k, DK)
    vc = to_chunks(v, DV)
    ic = gate_chunks(i_log)
    fc = gate_chunks(f_log)
    causal = jnp.tril(jnp.ones((L, L), dtype=bool))

    def step(carry, xs):
        C, n, m = carry
        q_, k_, v_, i_, f_ = xs
        b = jnp.cumsum(f_, axis=-1)
        dmat = jnp.where(causal, b[..., :, None] - b[..., None, :] + i_[..., None, :], -jnp.inf)
        inter = b + m[..., None]
        m_t = jnp.maximum(inter, jnp.max(dmat, axis=-1))
        w_intra = jnp.exp(dmat - m_t[..., None])
        w_inter = jnp.exp(inter - m_t)
        s = jnp.einsum('bhtd,bhsd->bhts', q_, k_) * w_intra
        num = jnp.einsum('bhts,bhsv->bhtv', s, v_) + w_inter[..., None] * jnp.einsum('bhtd,bhdv->bhtv', q_, C)
        den = jnp.sum(s, axis=-1) + w_inter * jnp.einsum('bhtd,bhd->bht', q_, n)
        den = jnp.maximum(jnp.abs(den), jnp.exp(-m_t))
        h_out = num / den[..., None]
        g_tot = b[..., -1]
        a = g_tot[..., None] - b + i_
        m_new = jnp.maximum(g_tot + m, jnp.max(a, axis=-1))
        decay = jnp.exp(g_tot + m - m_new)
        wa = jnp.exp(a - m_new[..., None])
        C_new = decay[..., None, None] * C + jnp.einsum('bhs,bhsd,bhsv->bhdv', wa, k_, v_)
        n_new = decay[..., None] * n + jnp.einsum('bhs,bhsd->bhd', wa, k_)
        return (C_new, n_new, m_new), h_out

    init = (jnp.zeros((B, NH, DK, DV), jnp.float32),
            jnp.zeros((B, NH, DK), jnp.float32),
            jnp.zeros((B, NH), jnp.float32))
    _, hs = lax.scan(step, init, (qc, kc, vc, ic, fc))
    hs = hs.transpose(1, 0, 3, 2, 4).reshape(B, S, NH, DV)
    hs = hs * lax.rsqrt(jnp.mean(hs * hs, axis=-1, keepdims=True) + EPS)
    hs = hs * head_gain.astype(jnp.float32).reshape(NH, DV)
    out = hs.reshape(B, S, NH * DV).astype(h.dtype) * jax.nn.sigmoid(o_pre)
    return out @ w_out


def moba_mixer(h, positions, w_qkv, w_out):
    B, S, _ = h.shape
    H, Dh, BLK, QB = ATTN_HEADS, ATTN_DH, MOBA_BLOCK, Q_BLOCK
    q, k, v = jnp.split(h @ w_qkv, 3, axis=-1)
    q = partial_rope(q.reshape(B, S, H, Dh), positions)
    k = partial_rope(k.reshape(B, S, H, Dh), positions)
    v = v.reshape(B, S, H, Dh)
    nb = -(-S // BLK)
    pad = nb * BLK - S
    k = jnp.pad(k, ((0, 0), (0, pad), (0, 0), (0, 0))).astype(jnp.float32)
    v = jnp.pad(v, ((0, 0), (0, pad), (0, 0), (0, 0))).astype(jnp.float32)
    kb = k.transpose(0, 2, 1, 3).reshape(B, H, nb, BLK, Dh)
    vb = v.transpose(0, 2, 1, 3).reshape(B, H, nb, BLK, Dh)
    counts = jnp.minimum(BLK, S - jnp.arange(nb) * BLK).astype(jnp.float32)
    kmean = jnp.sum(kb, axis=3) / counts[:, None]
    topk = min(MOBA_TOPK, nb)
    nqb = S // QB
    qblocks = q.astype(jnp.float32).transpose(0, 2, 1, 3).reshape(B, H, nqb, QB, Dh).transpose(2, 0, 1, 3, 4)
    bi = jnp.arange(B)[:, None, None, None]
    hi = jnp.arange(H)[None, :, None, None]
    scale = Dh ** -0.5
    blk_ids = jnp.arange(nb)

    def attend(args):
        qi, qf = args
        cur = (qi * QB) // BLK
        gate = jnp.einsum('bhqd,bhnd->bhqn', qf, kmean)
        gate = jnp.where(blk_ids < cur, gate, NEG)
        _, idx = lax.top_k(gate, topk)
        sel_ok = idx < cur
        ksel = kb[bi, hi, idx]
        vsel = vb[bi, hi, idx]
        s_sel = jnp.einsum('bhqd,bhqjkd->bhqjk', qf, ksel) * scale
        s_sel = jnp.where(sel_ok[..., None], s_sel, NEG).reshape(B, H, QB, topk * BLK)
        k_own = lax.dynamic_index_in_dim(kb, cur, axis=2, keepdims=False)
        v_own = lax.dynamic_index_in_dim(vb, cur, axis=2, keepdims=False)
        s_own = jnp.einsum('bhqd,bhkd->bhqk', qf, k_own) * scale
        qpos = qi * QB + jnp.arange(QB)
        kpos = cur * BLK + jnp.arange(BLK)
        s_own = jnp.where(kpos[None, :] <= qpos[:, None], s_own, NEG)
        p = jax.nn.softmax(jnp.concatenate([s_sel, s_own], axis=-1), axis=-1)
        p_sel = p[..., :topk * BLK].reshape(B, H, QB, topk, BLK)
        p_own = p[..., topk * BLK:]
        return (jnp.einsum('bhqjk,bhqjkd->bhqd', p_sel, vsel)
                + jnp.einsum('bhqk,bhkd->bhqd', p_own, v_own))

    outs = lax.map(attend, (jnp.arange(nqb), qblocks))
    o = outs.transpose(1, 0, 3, 2, 4).reshape(B, S, H * Dh).astype(h.dtype)
    return o @ w_out


def short_conv_mixer(h, w_in, conv_w, w_out):
    b_gate, c_gate, u = jnp.split(h @ w_in, 3, axis=-1)
    z = c_gate * u
    y = lax.conv_general_dilated(
        z, conv_w[:, None, :].astype(z.dtype), window_strides=(1,), padding=[(CONV_WIDTH - 1, 0)],
        dimension_numbers=('NWC', 'WIO', 'NWC'), feature_group_count=D_MODEL)
    return (b_gate * y) @ w_out


def stick_breaking_mixer(h, w_qkv, w_out):
    B, S, _ = h.shape
    H, Dh, QB = ATTN_HEADS, ATTN_DH, Q_BLOCK
    q, k, v = jnp.split(h @ w_qkv, 3, axis=-1)
    q = q.astype(jnp.float32).reshape(B, S, H, Dh).transpose(0, 2, 1, 3)
    k = k.astype(jnp.float32).reshape(B, S, H, Dh).transpose(0, 2, 1, 3)
    v = v.astype(jnp.float32).reshape(B, S, H, Dh).transpose(0, 2, 1, 3)
    nqb = S // QB
    qblocks = q.reshape(B, H, nqb, QB, Dh).transpose(2, 0, 1, 3, 4)
    kpos = jnp.arange(S)
    scale = Dh ** -0.5

    def attend(args):
        qi, qf = args
        z = jnp.einsum('bhqd,bhkd->bhqk', qf, k) * scale
        qpos = qi * QB + jnp.arange(QB)
        strict = kpos[None, :] < qpos[:, None]
        log_fail = jnp.where(strict, jax.nn.log_sigmoid(-z), 0.0)
        after = lax.cumsum(log_fail, axis=3, reverse=True) - log_fail
        a = jnp.exp(jnp.where(strict, jax.nn.log_sigmoid(z) + after, -jnp.inf))
        return jnp.einsum('bhqk,bhkd->bhqd', a, v)

    outs = lax.map(attend, (jnp.arange(nqb), qblocks))
    o = outs.transpose(1, 0, 3, 2, 4).reshape(B, S, H * Dh).astype(h.dtype)
    return o @ w_out


def swiglu(h, w_gate, w_up, w_down):
    return (jax.nn.silu(h @ w_gate) * (h @ w_up)) @ w_down


def setup_inputs(seed: int = 0) -> dict:
    key = jax.random.key(seed)
    ks = jax.random.split(key, 20)
    D, F = D_MODEL, FFN_HIDDEN
    n_a = (DEPTH + 3) // 4
    n_b = (DEPTH + 2) // 4
    n_c = (DEPTH + 1) // 4
    n_d = DEPTH // 4
    nrm = lambda k, shape, fan: jax.random.normal(k, shape, jnp.float32) * fan ** -0.5
    x = jax.random.normal(ks[0], (BATCH, SEQ, D), jnp.float32)
    positions = jnp.broadcast_to(jnp.arange(SEQ, dtype=jnp.int32), (BATCH, SEQ))
    norm_gains = 1.0 + 0.1 * jax.random.normal(ks[1], (DEPTH, 2, D), jnp.float32)
    mlstm_w_in = nrm(ks[2], (n_a, D, MLSTM_IN), D)
    ib = 0.1 * jax.random.normal(ks[3], (n_a, MLSTM_HEADS), jnp.float32)
    fb = 3.0 + 0.1 * jax.random.normal(ks[4], (n_a, MLSTM_HEADS), jnp.float32)
    mlstm_b_gate = jnp.concatenate([ib, fb], axis=-1)
    mlstm_head_gain = 1.0 + 0.1 * jax.random.normal(ks[5], (n_a, MLSTM_HEADS * MLSTM_DV), jnp.float32)
    mlstm_w_out = nrm(ks[6], (n_a, MLSTM_HEADS * MLSTM_DV, D), MLSTM_HEADS * MLSTM_DV)
    moba_w_qkv = nrm(ks[7], (n_b, D, 3 * D), D)
    moba_w_out = nrm(ks[8], (n_b, D, D), D)
    conv_w_in = nrm(ks[9], (n_c, D, 3 * D), D)
    conv_w = nrm(ks[10], (n_c, CONV_WIDTH, D), CONV_WIDTH)
    conv_w_out = nrm(ks[11], (n_c, D, D), D)
    sb_w_qkv = nrm(ks[12], (n_d, D, 3 * D), D)
    sb_w_out = nrm(ks[13], (n_d, D, D), D)
    ffn_w_gate = nrm(ks[14], (DEPTH, D, F), D)
    ffn_w_up = nrm(ks[15], (DEPTH, D, F), D)
    ffn_w_down = nrm(ks[16], (DEPTH, F, D), F)
    final_gain = 1.0 + 0.1 * jax.random.normal(ks[17], (D,), jnp.float32)
    return {"x": x, "positions": positions, "norm_gains": norm_gains,
            "mlstm_w_in": mlstm_w_in, "mlstm_b_gate": mlstm_b_gate,
            "mlstm_head_gain": mlstm_head_gain, "mlstm_w_out": mlstm_w_out,
            "moba_w_qkv": moba_w_qkv, "moba_w_out": moba_w_out,
            "conv_w_in": conv_w_in, "conv_w": conv_w, "conv_w_out": conv_w_out,
            "sb_w_qkv": sb_w_qkv, "sb_w_out": sb_w_out,
            "ffn_w_gate": ffn_w_gate, "ffn_w_up": ffn_w_up, "ffn_w_down": ffn_w_down,
            "final_gain": final_gain}


def reference(x, positions, norm_gains, mlstm_w_in, mlstm_b_gate, mlstm_head_gain, mlstm_w_out,
              moba_w_qkv, moba_w_out, conv_w_in, conv_w, conv_w_out, sb_w_qkv, sb_w_out,
              ffn_w_gate, ffn_w_up, ffn_w_down, final_gain):
    h = x
    for layer in range(DEPTH):
        kind = layer % N_MIXERS
        j = layer // N_MIXERS
        a = rms_norm(h, norm_gains[layer, 0])
        if kind == 0:
            mix = mlstm_mixer(a, mlstm_w_in[j], mlstm_b_gate[j], mlstm_head_gain[j], mlstm_w_out[j])
        elif kind == 1:
            mix = moba_mixer(a, positions, moba_w_qkv[j], moba_w_out[j])
        elif kind == 2:
            mix = short_conv_mixer(a, conv_w_in[j], conv_w[j], conv_w_out[j])
        else:
            mix = stick_breaking_mixer(a, sb_w_qkv[j], sb_w_out[j])
        h = h + mix
        h = h + swiglu(rms_norm(h, norm_gains[layer, 1]), ffn_w_gate[layer], ffn_w_up[layer], ffn_w_down[layer])
    return rms_norm(h, final_gain)
```

```cpp
#include <hip/hip_runtime.h>
#include <cstdio>
#include <cstdint>
namespace pg8 {
#define PG8_LAS __attribute__((address_space(3)))
typedef unsigned short bf16_t;
typedef short bf16x8 __attribute__((ext_vector_type(8)));
typedef float f32x4 __attribute__((ext_vector_type(4)));
typedef unsigned u32x4 __attribute__((ext_vector_type(4)));
constexpr int BM = 256, BK = 64, HALF = 128, HTB = HALF * BK * 2  , STAGE_BYTES = 8 * HTB, NXCD = 8, WGM = 8;

__host__ __device__ __forceinline__ int lds_byte(int r, int c) { const int st = (r >> 4) * 2 + (c >> 5), rr = r & 15, cc = c & 31, ob = rr * 64 + cc * 2; return st * 1024 + (ob ^ (((ob >> 9) & 1) << 5)); }
__host__ __device__ __forceinline__ void stage_rc(int b, int& R, int& C) { const int st = b / 1024, sb = b % 1024, swz = sb ^ (((sb >> 9) & 1) << 5); R = (st >> 1) * 16 + swz / 64; C = (st & 1) * 32 + (swz % 64) / 2; }
__host__ __device__ __forceinline__ int perm32(int rho) { const int n = rho >> 4, i = rho & 15; return 8 * (i >> 2) + 4 * n + (i & 3); }

struct Unit { int pm, pn; };
struct Gemm { const bf16_t* A; const bf16_t* Bt; int M, N, K; };

struct StaticOrder {
    int nM, nN, nwg, G, c;
    __host__ __device__ void init(int M, int N, int G_, int c_) { nM = M / BM; nN = N / BM; nwg = nM * nN; G = G_; c = c_; }
    __host__ __device__ bool next(int i, Unit& u) const {
        const long L = (long)i * G + c; if (L >= nwg) return false;
        int wgid = (int)L; { const int q = nwg / NXCD, r = nwg % NXCD, xcd = wgid % NXCD, off = wgid / NXCD; wgid = (xcd < r ? xcd * (q + 1) : r * (q + 1) + (xcd - r) * q) + off; }
        const int nig = WGM * nN, gid = wgid / nig, fm = gid * WGM, gsz = (nM - fm) < WGM ? (nM - fm) : WGM;
        u.pm = fm + ((wgid % nig) % gsz); u.pn = (wgid % nig) / gsz; return true;
    }
    __device__ __forceinline__ void a_ready(const Unit&) const {}
    __device__ __forceinline__ void done(const Unit&) const {}
};

__device__ __forceinline__ unsigned cvt_pk_bf16(float lo, float hi) { unsigned r; asm volatile("v_cvt_pk_bf16_f32 %0, %1, %2" : "=v"(r) : "v"(lo), "v"(hi)); return r; }
constexpr int SEQ = 16384, DM = 1024;
constexpr float RMS_EPS = 1e-6f;
__device__ __forceinline__ float row_rs(const float* ss, int row) {
    const f32x4* p = (const f32x4*)(ss + (size_t)row * 16); const f32x4 a = p[0], b = p[1], c = p[2], d = p[3];
    const float s = (((a[0] + a[1]) + (a[2] + a[3])) + ((b[0] + b[1]) + (b[2] + b[3]))) + (((c[0] + c[1]) + (c[2] + c[3])) + ((d[0] + d[1]) + (d[2] + d[3])));
    return 1.0f / sqrtf(s * (1.0f / 1024.0f) + RMS_EPS);
}
template <int MODE> struct EpiIn {
    static constexpr bool PERM = true, AFTER_DRAIN = false;
    bf16_t* O; const float* ss; const float* rope; int nsc; float scale0;
    __device__ __forceinline__ void operator()(const f32x4 (&acc)[2][2][4][2], const Unit& u, int wr, int wc, int fr, int fq) const {
        const int row0 = u.pm * BM + wr * 64 + fr;
        if (MODE == 2 && u.pn >= 4) {
            bf16_t* base = O + (size_t)SEQ * DM + (u.pn - 4) * 128 + wc * 32 + 8 * fq;
#pragma unroll
            for (int ai = 0; ai < 2; ++ai)
#pragma unroll
                for (int m = 0; m < 4; ++m) { const int row = row0 + ai * HALF + m * 16; const float rs = row_rs(ss, row), r2 = rs * rs;
                    const f32x4 v0 = acc[ai][0][m][0] * acc[ai][1][m][0] * r2, v1 = acc[ai][0][m][1] * acc[ai][1][m][1] * r2;
                    u32x4 w; w.x = cvt_pk_bf16(v0[0], v0[1]); w.y = cvt_pk_bf16(v0[2], v0[3]); w.z = cvt_pk_bf16(v1[0], v1[1]); w.w = cvt_pk_bf16(v1[2], v1[3]);
                    *(u32x4*)(base + (size_t)row * DM) = w; }
            return;
        }
        const int t = u.pn >> 2; bf16_t* base = O + (size_t)t * SEQ * DM + (u.pn & 3) * BM + wc * 32 + 8 * fq;
        const float sc = (u.pn < nsc) ? scale0 : 1.0f;
        const bool rot = (MODE == 1) && (t < 2) && ((wc & 1) == 0);
#pragma unroll
        for (int ai = 0; ai < 2; ++ai)
#pragma unroll
            for (int m = 0; m < 4; ++m) { const int row = row0 + ai * HALF + m * 16; const float rs = row_rs(ss, row) * sc;
                f32x4 c0 = {1.f, 1.f, 1.f, 1.f}, c1 = c0, s0 = {0.f, 0.f, 0.f, 0.f}, s1 = s0;
                if (MODE == 1) { if (rot) { const f32x4* rp = (const f32x4*)(rope + (size_t)row * 16); c0 = rp[0]; c1 = rp[1]; s0 = rp[2]; s1 = rp[3]; if (fq == 0) { s0 = -s0; s1 = -s1; } } }
#pragma unroll
                for (int bj = 0; bj < 2; ++bj) { f32x4 v0 = acc[ai][bj][m][0] * rs, v1 = acc[ai][bj][m][1] * rs;
                    if (MODE == 1) { if (rot) {
                        f32x4 p0, p1;
#pragma unroll
                        for (int e = 0; e < 4; ++e) { p0[e] = __shfl_xor(v0[e], 16); p1[e] = __shfl_xor(v1[e], 16); }
                        if (fq < 2) { v0 = v0 * c0 + p0 * s0; v1 = v1 * c1 + p1 * s1; } } }
                    u32x4 w; w.x = cvt_pk_bf16(v0[0], v0[1]); w.y = cvt_pk_bf16(v0[2], v0[3]); w.z = cvt_pk_bf16(v1[0], v1[1]); w.w = cvt_pk_bf16(v1[2], v1[3]);
                    *(u32x4*)(base + (size_t)row * DM + bj * HALF) = w; } }
    }
};
struct EpiRes {
    static constexpr bool PERM = true, AFTER_DRAIN = false;
    const float* res; float* hout; bf16_t* hb; float* ss;
    __device__ __forceinline__ void operator()(const f32x4 (&acc)[2][2][4][2], const Unit& u, int wr, int wc, int fr, int fq) const {
        const int row0 = u.pm * BM + wr * 64 + fr, col0 = u.pn * BM + wc * 32 + 8 * fq;
#pragma unroll
        for (int ai = 0; ai < 2; ++ai)
#pragma unroll
            for (int m = 0; m < 4; ++m) { const int row = row0 + ai * HALF + m * 16; const size_t off = (size_t)row * DM + col0; float q = 0.f;
#pragma unroll
                for (int bj = 0; bj < 2; ++bj) { const f32x4 r0 = *(const f32x4*)(res + off + bj * HALF), r1 = *(const f32x4*)(res + off + bj * HALF + 4);
                    const f32x4 h0 = r0 + acc[ai][bj][m][0], h1 = r1 + acc[ai][bj][m][1];
                    *(f32x4*)(hout + off + bj * HALF) = h0; *(f32x4*)(hout + off + bj * HALF + 4) = h1;
                    u32x4 w; w.x = cvt_pk_bf16(h0[0], h0[1]); w.y = cvt_pk_bf16(h0[2], h0[3]); w.z = cvt_pk_bf16(h1[0], h1[1]); w.w = cvt_pk_bf16(h1[2], h1[3]);
                    *(u32x4*)(hb + off + bj * HALF) = w;
                    q += ((h0[0] * h0[0] + h0[1] * h0[1]) + (h0[2] * h0[2] + h0[3] * h0[3])) + ((h1[0] * h1[0] + h1[1] * h1[1]) + (h1[2] * h1[2] + h1[3] * h1[3])); }
                q += __shfl_xor(q, 16); q += __shfl_xor(q, 32);
                if (fq == 0) ss[(size_t)row * 16 + u.pn * 4 + wc] = q;
                asm volatile("" ::: "memory"); }
    }
};
struct EpiGlu {
    static constexpr bool PERM = true, AFTER_DRAIN = false;
    bf16_t* Hd; int ldh; const float* ss;
    __device__ __forceinline__ void operator()(const f32x4 (&acc)[2][2][4][2], const Unit& u, int wr, int wc, int fr, int fq) const {
        const int row0 = u.pm * BM + wr * 64 + fr; bf16_t* base = Hd + u.pn * 128 + wc * 32 + 8 * fq;
#pragma unroll
        for (int ai = 0; ai < 2; ++ai)
#pragma unroll
            for (int m = 0; m < 4; ++m) { const int row = row0 + ai * HALF + m * 16; const float rs = row_rs(ss, row); float o[8];
#pragma unroll
                for (int n = 0; n < 2; ++n)
#pragma unroll
                    for (int e = 0; e < 4; ++e) { const float g = acc[ai][0][m][n][e] * rs, up = acc[ai][1][m][n][e] * rs;
                        o[n * 4 + e] = g * __builtin_amdgcn_rcpf(1.0f + __builtin_amdgcn_exp2f(g * -1.4426950408889634f)) * up; }
                u32x4 w; w.x = cvt_pk_bf16(o[0], o[1]); w.y = cvt_pk_bf16(o[2], o[3]); w.z = cvt_pk_bf16(o[4], o[5]); w.w = cvt_pk_bf16(o[6], o[7]);
                *(u32x4*)(base + (size_t)row * ldh) = w; }
    }
};

template <class Epi, class Sched, bool ALIGN_EPI = false, bool SP2 = false>
__device__ __forceinline__ void gemm_phase(PG8_LAS unsigned char* lds, const Gemm g, const Sched& S, const Epi& E) {
    const int tid = threadIdx.x, wid = __builtin_amdgcn_readfirstlane(tid >> 6), lane = tid & 63, wr = wid >> 2, wc = wid & 3, fr = lane & 15, fq = lane >> 4;
    const int K = g.K, nt = K / BK;
    unsigned voffA[2], voffB[2];
#pragma unroll
    for (int i = 0; i < 2; ++i) { int R, C; stage_rc(tid * 16 + i * 8192, R, C); const int Rb = Epi::PERM ? ((R & ~31) + perm32(R & 31)) : R;
        voffA[i] = (unsigned)(R * K + C) * 2u; voffB[i] = (unsigned)(Rb * K + C) * 2u; }
    const size_t kstep = (size_t)(BK * 2);
    const size_t hstep = (size_t)HALF * K * 2;
    const size_t tstep = 2 * hstep;
    const unsigned ldsw = (unsigned)wid * 1024u;
    const int aoff = lds_byte(wr * 64 + fr, fq * 8), boff = lds_byte(wc * 32 + fr, fq * 8);
#define PG8_SA(b, h) (((b) * 2 + (h)) * HTB)
#define PG8_SB(b, h) ((4 + (b) * 2 + (h)) * HTB)
#define PG8_STAGE(bufoff, gbase, voff) do { _Pragma("unroll") for (int _i = 0; _i < 2; ++_i) \
        __builtin_amdgcn_global_load_lds((const unsigned*)((const char*)(gbase) + (voff)[_i]), (PG8_LAS unsigned*)(lds + (bufoff) + ldsw + _i * 8192), 16, 0, 0); } while (0)
#define PG8_LDA(dst, b, h) do { _Pragma("unroll") for (int m = 0; m < 4; ++m) _Pragma("unroll") for (int k = 0; k < 2; ++k) dst[m][k] = *(const PG8_LAS bf16x8*)(lds + PG8_SA(b, h) + aoff + m * 2048 + k * 1024); } while (0)
#define PG8_LDB(dst, b, h) do { _Pragma("unroll") for (int n = 0; n < 2; ++n) _Pragma("unroll") for (int k = 0; k < 2; ++k) dst[n][k] = *(const PG8_LAS bf16x8*)(lds + PG8_SB(b, h) + boff + n * 2048 + k * 1024); } while (0)
#define PG8_MMA(ai, bj, At, Bt) do { __builtin_amdgcn_s_setprio(1); _Pragma("unroll") for (int m = 0; m < 4; ++m) _Pragma("unroll") for (int n = 0; n < 2; ++n) _Pragma("unroll") for (int k = 0; k < 2; ++k) \
        acc[ai][bj][m][n] = __builtin_amdgcn_mfma_f32_16x16x32_bf16(Bt[n][k], At[m][k], acc[ai][bj][m][n], 0, 0, 0); __builtin_amdgcn_s_setprio(0); } while (0)
#define PG8_WAIT_V(n) asm volatile("s_waitcnt vmcnt(" #n ")" ::: "memory")
#define PG8_WAIT_L(n) asm volatile("s_waitcnt lgkmcnt(" #n ")" ::: "memory")
#define PG8_BAR __builtin_amdgcn_s_barrier()
#define PG8_SCHED __builtin_amdgcn_sched_barrier(0)
    Unit cur, nxt; int ui = 0;
    if (!S.next(0, cur)) return;
    f32x4 acc[2][2][4][2];
#pragma unroll
    for (int a = 0; a < 2; ++a)
#pragma unroll
        for (int b = 0; b < 2; ++b)
#pragma unroll
            for (int m = 0; m < 4; ++m)
#pragma unroll
                for (int n = 0; n < 2; ++n) acc[a][b][m][n] = (f32x4){0.f, 0.f, 0.f, 0.f};
    bf16x8 At[4][2], B0[2][2], B1[2][2];
    const char* cA = (const char*)g.A + (size_t)cur.pm * tstep; const char* cB = (const char*)g.Bt + (size_t)cur.pn * tstep;
    S.a_ready(cur);
    if constexpr (SP2) {
        PG8_STAGE(PG8_SB(0, 0), cB, voffB); PG8_STAGE(PG8_SB(0, 1), cB + hstep, voffB); PG8_STAGE(PG8_SA(0, 0), cA, voffA); PG8_STAGE(PG8_SA(0, 1), cA + hstep, voffA);
        if (wr == 1) PG8_BAR;
        PG8_WAIT_V(2); PG8_BAR;
        PG8_STAGE(PG8_SB(1, 0), cB + kstep, voffB); PG8_STAGE(PG8_SA(1, 0), cA + kstep, voffA); PG8_STAGE(PG8_SB(1, 1), cB + hstep + kstep, voffB);
        PG8_WAIT_V(6); PG8_BAR;
    } else {
        PG8_STAGE(PG8_SB(0, 0), cB, voffB); PG8_STAGE(PG8_SA(0, 0), cA, voffA); PG8_STAGE(PG8_SB(0, 1), cB + hstep, voffB); PG8_STAGE(PG8_SA(0, 1), cA + hstep, voffA);
        if (wr == 1) PG8_BAR;
        PG8_WAIT_V(4); PG8_BAR;
        PG8_STAGE(PG8_SB(1, 0), cB + kstep, voffB); PG8_STAGE(PG8_SA(1, 0), cA + kstep, voffA); PG8_STAGE(PG8_SB(1, 1), cB + hstep + kstep, voffB);
        PG8_WAIT_V(6); PG8_BAR;
    }
    for (;;) {
        const bool has_next = S.next(ui + 1, nxt);
        const char* nA = has_next ? (const char*)g.A + (size_t)nxt.pm * tstep : cA; const char* nB = has_next ? (const char*)g.Bt + (size_t)nxt.pn * tstep : cB;
        for (int t = 0; t < nt; t += 2) {
            const bool last = (t == nt - 2);
            const char* a1 = cA + (size_t)(t + 1) * kstep;
            const char* a2 = last ? nA : cA + (size_t)(t + 2) * kstep; const char* b2 = last ? nB : cB + (size_t)(t + 2) * kstep;
            const char* a3 = a2 + kstep; const char* b3 = b2 + kstep;
            if (last && has_next) S.a_ready(nxt);
            if constexpr (SP2) {
            PG8_LDB(B0, 0, 0); PG8_LDB(B1, 0, 1); PG8_SCHED; PG8_LDA(At, 0, 0); PG8_STAGE(PG8_SA(1, 1), a1 + hstep, voffA);
            PG8_WAIT_V(8); PG8_WAIT_L(0); PG8_BAR; PG8_MMA(0, 0, At, B0); PG8_MMA(0, 1, At, B1); PG8_BAR; PG8_SCHED;
            PG8_LDA(At, 0, 1); PG8_STAGE(PG8_SB(0, 0), b2, voffB); PG8_STAGE(PG8_SB(0, 1), b2 + hstep, voffB); PG8_STAGE(PG8_SA(0, 0), a2, voffA);
            PG8_WAIT_V(8); PG8_WAIT_L(0); PG8_BAR; PG8_MMA(1, 0, At, B0); PG8_MMA(1, 1, At, B1); PG8_BAR; PG8_SCHED;
            PG8_LDB(B0, 1, 0); PG8_LDB(B1, 1, 1); PG8_SCHED; PG8_LDA(At, 1, 0); PG8_STAGE(PG8_SA(0, 1), a2 + hstep, voffA);
            PG8_WAIT_V(8); PG8_WAIT_L(0); PG8_BAR; PG8_MMA(0, 0, At, B0); PG8_MMA(0, 1, At, B1); PG8_BAR; PG8_SCHED;
            PG8_LDA(At, 1, 1); PG8_STAGE(PG8_SB(1, 0), b3, voffB); PG8_STAGE(PG8_SB(1, 1), b3 + hstep, voffB); PG8_STAGE(PG8_SA(1, 0), a3, voffA);
            PG8_WAIT_V(8); PG8_WAIT_L(0); PG8_BAR; PG8_MMA(1, 0, At, B0); PG8_MMA(1, 1, At, B1); PG8_BAR; PG8_SCHED;
            } else {
            PG8_LDB(B0, 0, 0); PG8_SCHED; PG8_LDA(At, 0, 0); PG8_STAGE(PG8_SA(1, 1), a1 + hstep, voffA);
            PG8_WAIT_L(8); PG8_BAR; PG8_WAIT_L(0); PG8_MMA(0, 0, At, B0); PG8_BAR; PG8_SCHED;
            PG8_LDB(B1, 0, 1); PG8_STAGE(PG8_SB(0, 0), b2, voffB);
            PG8_BAR; PG8_WAIT_L(0); PG8_MMA(0, 1, At, B1); PG8_BAR;
            PG8_LDA(At, 0, 1); PG8_STAGE(PG8_SA(0, 0), a2, voffA);
            PG8_BAR; PG8_WAIT_L(0); PG8_MMA(1, 0, At, B0); PG8_BAR; PG8_SCHED;
            PG8_STAGE(PG8_SB(0, 1), b2 + hstep, voffB);
            PG8_WAIT_V(6); PG8_BAR; PG8_MMA(1, 1, At, B1); PG8_BAR;
            PG8_LDB(B0, 1, 0); PG8_SCHED; PG8_LDA(At, 1, 0); PG8_STAGE(PG8_SA(0, 1), a2 + hstep, voffA);
            PG8_WAIT_L(8); PG8_BAR; PG8_WAIT_L(0); PG8_MMA(0, 0, At, B0); PG8_BAR; PG8_SCHED;
            PG8_LDB(B1, 1, 1); PG8_STAGE(PG8_SB(1, 0), b3, voffB);
            PG8_BAR; PG8_WAIT_L(0); PG8_MMA(0, 1, At, B1); PG8_BAR;
            PG8_LDA(At, 1, 1); PG8_STAGE(PG8_SA(1, 0), a3, voffA);
            PG8_BAR; PG8_WAIT_L(0); PG8_MMA(1, 0, At, B0); PG8_BAR; PG8_SCHED;
            PG8_STAGE(PG8_SB(1, 1), b3 + hstep, voffB);
            PG8_WAIT_V(6); PG8_BAR; PG8_MMA(1, 1, At, B1); PG8_BAR;
            }
        }
        if constexpr (ALIGN_EPI) { if (wr == 0) PG8_BAR; }
        if constexpr (!Epi::AFTER_DRAIN) { E(acc, cur, wr, wc, fr, fq); S.done(cur); }
        if (!has_next) break;
#pragma unroll
        for (int a = 0; a < 2; ++a)
#pragma unroll
            for (int b = 0; b < 2; ++b)
#pragma unroll
                for (int m = 0; m < 4; ++m)
#pragma unroll
                    for (int n = 0; n < 2; ++n) acc[a][b][m][n] = (f32x4){0.f, 0.f, 0.f, 0.f};
        cur = nxt; cA = nA; cB = nB; ++ui;
        if constexpr (ALIGN_EPI) { if (wr == 1) PG8_BAR; }
    }
    PG8_WAIT_V(0);
    if constexpr (!ALIGN_EPI) { if (wr == 0) PG8_BAR; }
    PG8_BAR;
    if constexpr (Epi::AFTER_DRAIN) { E.fused(acc, cur, wr, wc, fr, fq, lds, wid, lane); S.done(cur); }
#undef PG8_SA
#undef PG8_SB
#undef PG8_STAGE
#undef PG8_LDA
#undef PG8_LDB
#undef PG8_MMA
#undef PG8_WAIT_V
#undef PG8_WAIT_L
#undef PG8_BAR
#undef PG8_SCHED
}
}

constexpr int NWAVES = 8;
constexpr int S = 16384, D = 1024, FF = 2816, NHEAD = 16, DH = 64;
constexpr int ML_H = 4, ML_DK = 128, ML_DV = 256, ML_L = 128, ML_NC = S / ML_L, ML_IN = 3080;
constexpr int MB_BLK = 256, MB_NB = S / MB_BLK;
constexpr float EPS = 1e-6f;
constexpr float C2 = 0.125f * 1.4426950408889634f;
#ifndef MK_PER_PHASE
#define MK_PER_PHASE 0
#endif
constexpr int NPHASE = 28;

constexpr size_t MiB = 1u << 20;
constexpr size_t WS_CTL = 0, CTL_ZERO_BYTES = 64 * 1024;
constexpr size_t WS_SS = 1 * MiB;
constexpr size_t WS_GATES = 2 * MiB;
constexpr size_t WS_ROPE = 3 * MiB;
constexpr size_t WS_GA = 4 * MiB;
constexpr size_t WS_MST = WS_GA + 8192;
constexpr size_t WS_ND = WS_GA + 16384;
constexpr size_t WS_NST = WS_ND + 262144;
constexpr size_t WS_KMEAN = WS_NST + 262144;
constexpr size_t WS_CNT = WS_KMEAN + 262144;
constexpr size_t WS_WIN = 8 * MiB, WS_WOUT = 14 * MiB, WS_WGU = 16 * MiB, WS_WD = 27 * MiB;
constexpr size_t WS_T0 = 33 * MiB, WS_T1 = 65 * MiB, WS_T2 = 97 * MiB;
constexpr size_t WS_X = 129 * MiB;
constexpr size_t WS_HB = WS_X;
constexpr size_t WS_DT = WS_X, WS_CT = WS_X + 64 * MiB;
constexpr size_t WS_PO = WS_X, WS_LSE = WS_X + 96 * MiB, WS_SEL = WS_X + 100 * MiB, WS_LIST = WS_X + 101 * MiB;
constexpr size_t WS_END = WS_LIST + 17 * MiB;
static_assert(WS_END <= 256 * MiB, "workspace map");
constexpr int LIST_HEAD_CAP = 256 * 2016;
constexpr int CW_BAR = 1024;

constexpr int LDS_BYTES = 147456;
constexpr int MISC_OFF = LDS_BYTES - 256;
constexpr int CONV_SCR = 8704, AUX_OFF = 8 * CONV_SCR;
constexpr int SCAL_OFF = 139264;

#define GAS __attribute__((address_space(1)))
#define LAS __attribute__((address_space(3)))
typedef unsigned short bf16;
typedef unsigned v4u __attribute__((ext_vector_type(4)));
typedef unsigned v2u __attribute__((ext_vector_type(2)));
typedef float f32x4 __attribute__((ext_vector_type(4)));
typedef float f32x16 __attribute__((ext_vector_type(16)));
typedef short bf16x8 __attribute__((ext_vector_type(8)));
typedef short s16x4 __attribute__((ext_vector_type(4)));
typedef GAS unsigned gu32;
#define RLX_AGENT __ATOMIC_RELAXED, __HIP_MEMORY_SCOPE_AGENT
#define LDS_WAIT() asm volatile("s_waitcnt lgkmcnt(0)" ::: "memory")
#define VM_WAIT() asm volatile("s_waitcnt vmcnt(0)" ::: "memory")
__device__ __forceinline__ unsigned f2bf(float f) { unsigned u = __builtin_bit_cast(unsigned, f); return (u + 0x7fffu + ((u >> 16) & 1u)) >> 16; }
__device__ __forceinline__ unsigned pk2(float lo, float hi) { return pg8::cvt_pk_bf16(lo, hi); }
__device__ __forceinline__ float bf_lo(unsigned w) { return __builtin_bit_cast(float, w << 16); }
__device__ __forceinline__ float bf_hi(unsigned w) { return __builtin_bit_cast(float, w & 0xffff0000u); }
__device__ __forceinline__ float ex2(float x) { return __builtin_amdgcn_exp2f(x); }
__device__ __forceinline__ float lg2(float x) { return __builtin_amdgcn_logf(x); }
__device__ __forceinline__ int crow(int r, int hi) { return (r & 3) + 8 * (r >> 2) + 4 * hi; }
#define MFMA32(a, b, c) __builtin_amdgcn_mfma_f32_32x32x16_bf16((a), (b), (c), 0, 0, 0)
typedef short v4i16_t __attribute__((ext_vector_type(4)));
__device__ __forceinline__ s16x4 ldtr(LAS const unsigned char* p) { return __builtin_bit_cast(s16x4, __builtin_amdgcn_ds_read_tr16_b64_v4i16((LAS v4i16_t*)p)); }
__device__ __forceinline__ bf16x8 cat8(s16x4 a, s16x4 b) { return (bf16x8){a[0], a[1], a[2], a[3], b[0], b[1], b[2], b[3]}; }
__device__ __forceinline__ int tr_lane_off(int lane, int stride) { return ((lane & 15) >> 2) * stride + (((lane >> 4) & 1) * 16 + (lane & 3) * 4) * 2; }
__device__ __forceinline__ bf16x8 frag_tr_nat(LAS const unsigned char* tile, int stride, int k0, int n0, int lane, int troff) {
    LAS const unsigned char* p = tile + (k0 + 8 * (lane >> 5)) * stride + n0 * 2 + troff; return cat8(ldtr(p), ldtr(p + 4 * stride)); }
__device__ __forceinline__ bf16x8 frag_tr_acc(LAS const unsigned char* tile, int stride, int k0, int n0, int lane, int troff) {
    LAS const unsigned char* p = tile + (k0 + 4 * (lane >> 5)) * stride + n0 * 2 + troff; return cat8(ldtr(p), ldtr(p + 8 * stride)); }
__device__ __forceinline__ bf16x8 frag_row(LAS const unsigned char* tile, int stride, int r0, int c0, int lane) {
    return *(LAS const bf16x8*)(tile + (r0 + (lane & 31)) * stride + (c0 + 8 * (lane >> 5)) * 2); }
__device__ __forceinline__ bf16x8 pack_acc(const f32x16& p, int s) {
    v4u w; w.x = pk2(p[8 * s + 0], p[8 * s + 1]); w.y = pk2(p[8 * s + 2], p[8 * s + 3]); w.z = pk2(p[8 * s + 4], p[8 * s + 5]); w.w = pk2(p[8 * s + 6], p[8 * s + 7]); return __builtin_bit_cast(bf16x8, w); }
__device__ __forceinline__ float wave_sum(float v) {
#pragma unroll
    for (int o = 1; o < 64; o <<= 1) v += __shfl_xor(v, o);
    return v;
}
__device__ __forceinline__ float wave_max(float v) {
#pragma unroll
    for (int o = 1; o < 64; o <<= 1) v = fmaxf(v, __shfl_xor(v, o));
    return v;
}
#define XB_TMO      128
#define XB_XCNT(j)  (256  + 64 * (j))
#define XB_XSUB(j)  (1280 + 64 * (j))
#define XB_XGEN(j)  (2304 + 64 * (j))
#define XB_TOP      3328
#define XB_TOPGEN   3392
#define XCD_BAR_WORDS 3456
#define XB_SPIN_CAP (1u << 18)

__device__ __forceinline__ unsigned xb_ld(unsigned* p)              { return __hip_atomic_load(p, __ATOMIC_RELAXED, __HIP_MEMORY_SCOPE_AGENT); }
__device__ __forceinline__ unsigned xb_add(unsigned* p, unsigned v) { return __hip_atomic_fetch_add(p, v, __ATOMIC_RELAXED, __HIP_MEMORY_SCOPE_AGENT); }
__device__ __forceinline__ unsigned xb_xcc_id() { return (unsigned)__builtin_amdgcn_s_getreg((3 << 11) | 20) & 0xFu; }
#define XB_SPIN(cond, bar) do { unsigned _sp = 0; while (cond) { __builtin_amdgcn_s_sleep(1); \
    if ((++_sp & 255u) == 0u) { if (xb_ld(&(bar)[XB_TMO])) break; if (_sp > XB_SPIN_CAP) { atomicAdd(&(bar)[XB_TMO], 1u); break; } } } } while (0)

struct XcdBarrier {
    unsigned* bar; unsigned x;
    volatile LAS unsigned* st;
};

__device__ __forceinline__ XcdBarrier xcd_barrier_post(unsigned* bar, volatile LAS unsigned* st) {
    XcdBarrier b; b.bar = bar; b.x = xb_xcc_id(); b.st = st;
    if (threadIdx.x == 0) (void)xb_add(&bar[XB_XCNT(b.x)], 1u);
    return b;
}
__device__ __forceinline__ void xcd_barrier_complete(unsigned* bar, unsigned x, unsigned& nloc, unsigned& nx) {
    const unsigned G = gridDim.x * gridDim.y * gridDim.z;
    unsigned sum, cnt, mine, sp = 0u;
    for (;;) {
        sum = 0u; cnt = 0u; mine = 0u;
#pragma unroll
        for (unsigned j = 0; j < 16; ++j) { const unsigned c = xb_ld(&bar[XB_XCNT(j)]); sum += c; cnt += (c > 0u) ? 1u : 0u; mine = (j == x) ? c : mine; }
        if (sum == G) break;
        __builtin_amdgcn_s_sleep(1);
        if ((++sp & 255u) == 0u) { if (xb_ld(&bar[XB_TMO])) break; if (sp > XB_SPIN_CAP) { atomicAdd(&bar[XB_TMO], 1u); break; } }
    }
    nloc = mine > 0u ? mine : 1u; nx = cnt > 0u ? cnt : 1u;
}

__device__ __forceinline__ void xcd_barrier(const XcdBarrier& b) {
    asm volatile("s_waitcnt vmcnt(0)" ::: "memory");
    __syncthreads();
    if (threadIdx.x == 0) {
        unsigned* bar = b.bar;
        __builtin_amdgcn_s_waitcnt(0);
        unsigned nloc = b.st[0], nx = b.st[1];
        if (nloc == 0u) { xcd_barrier_complete(bar, b.x, nloc, nx); b.st[0] = nloc; b.st[1] = nx; }
        const unsigned old = xb_add(&bar[XB_XSUB(b.x)], 1u);
        const unsigned gen = old / nloc;
        if (old + 1u == (gen + 1u) * nloc) {
            __builtin_amdgcn_fence(__ATOMIC_RELEASE, "agent");
            asm volatile("s_waitcnt vmcnt(0)" ::: "memory");
            const unsigned og = xb_add(&bar[XB_TOP], 1u);
            const unsigned tg = og / nx;
            if (og + 1u == (tg + 1u) * nx) xb_add(&bar[XB_TOPGEN], 1u);
            else XB_SPIN(xb_ld(&bar[XB_TOPGEN]) == tg, bar);
            __builtin_amdgcn_fence(__ATOMIC_ACQUIRE, "agent");
            xb_add(&bar[XB_XGEN(b.x)], 1u);
            asm volatile("s_waitcnt vmcnt(0)" ::: "memory");
        } else {
            XB_SPIN(xb_ld(&bar[XB_XGEN(b.x)]) == gen, bar);
            __builtin_amdgcn_fence(__ATOMIC_ACQUIRE, "agent");
            asm volatile("s_waitcnt vmcnt(0)" ::: "memory");
        }
    }
    __syncthreads();
}

struct Frame {
    LAS unsigned char* lds;
    volatile LAS unsigned* MISC;
    gu32* ctl;
    int tid, lane, wave;
    int G;
    unsigned char* ws;
    const float* in[18]; float* out;
};
#define WSP(T, off) ((T*)(F.ws + (off)))

__device__ __forceinline__ void tr_item(const float* W, int ldw, const float* gain, bf16* WT, int K, int k0, int n0, int orow0, LAS float* scr, int lane) {
#pragma unroll 8
    for (int i = 0; i < 32; ++i) { const int kk = 2 * i + (lane >> 5); float v = W[(size_t)(k0 + kk) * ldw + n0 + (lane & 31)]; if (gain) v *= gain[k0 + kk]; scr[kk * 33 + (lane & 31)] = v; }
    LDS_WAIT(); asm volatile("" ::: "memory");
    const int c = lane & 7;
#pragma unroll
    for (int j = 0; j < 4; ++j) { const int n = (lane >> 3) + 8 * j; const LAS float* s = scr + (8 * c) * 33 + n;
        v4u o; o.x = pk2(s[0 * 33], s[1 * 33]); o.y = pk2(s[2 * 33], s[3 * 33]); o.z = pk2(s[4 * 33], s[5 * 33]); o.w = pk2(s[6 * 33], s[7 * 33]);
        *(GAS v4u*)(WT + (size_t)(orow0 + n) * K + k0 + 8 * c) = o; }
    LDS_WAIT(); asm volatile("" ::: "memory");
}
__device__ __forceinline__ void convert_matrix(Frame& F, const float* W, int ldw, int K, int N, const float* gain, bf16* WT, int kind, int half, int base, int& cursor, LAS float* scr) {
    const int gw = blockIdx.x * NWAVES + F.wave, NGW = F.G * NWAVES; const int nblk = N / 32, nitems = (K / 64) * nblk;
    for (int it = (gw + NGW - (cursor % NGW)) % NGW; it < nitems; it += NGW) { const int kb = it / nblk, nb = it % nblk, n0 = 32 * nb;
        const int orow0 = (kind == 0) ? base + n0 : base + (n0 >> 7) * 256 + half * 128 + (n0 & 127);
        tr_item(W, ldw, gain, WT, K, 64 * kb, n0, orow0, scr, F.lane); }
    cursor += nitems;
}
__device__ __forceinline__ void convert_win(Frame& F, int layer) {
    LAS float* scr = (LAS float*)(F.lds + F.wave * CONV_SCR); int cur = 0; const float* g = F.in[2] + (size_t)layer * 2 * D; bf16* WT = WSP(bf16, WS_WIN);
    if (layer == 0) convert_matrix(F, F.in[3], ML_IN, D, 3 * D, g, WT, 0, 0, 0, cur, scr);
    else if (layer == 1) convert_matrix(F, F.in[7], 3 * D, D, 3 * D, g, WT, 0, 0, 0, cur, scr);
    else if (layer == 3) convert_matrix(F, F.in[12], 3 * D, D, 3 * D, g, WT, 0, 0, 0, cur, scr);
    else { convert_matrix(F, F.in[9], 3 * D, D, D, g, WT, 0, 0, 0, cur, scr);
           convert_matrix(F, F.in[9] + D, 3 * D, D, D, g, WT, 1, 0, D, cur, scr);
           convert_matrix(F, F.in[9] + 2 * D, 3 * D, D, D, g, WT, 1, 1, D, cur, scr); }
}
__device__ __forceinline__ void convert_rest(Frame& F, int layer) {
    LAS float* scr = (LAS float*)(F.lds + F.wave * CONV_SCR); int cur = 0; const float* g = F.in[2] + (size_t)layer * 2 * D + D;
    const float* wo = (layer == 0) ? F.in[6] : (layer == 1) ? F.in[8] : (layer == 2) ? F.in[11] : F.in[13];
    convert_matrix(F, wo, D, D, D, nullptr, WSP(bf16, WS_WOUT), 0, 0, 0, cur, scr);
    convert_matrix(F, F.in[14] + (size_t)layer * D * FF, FF, D, FF, g, WSP(bf16, WS_WGU), 1, 0, 0, cur, scr);
    convert_matrix(F, F.in[15] + (size_t)layer * D * FF, FF, D, FF, g, WSP(bf16, WS_WGU), 1, 1, 0, cur, scr);
    convert_matrix(F, F.in[16] + (size_t)layer * FF * D, D, FF, D, nullptr, WSP(bf16, WS_WD), 0, 0, 0, cur, scr);
}

__device__ __forceinline__ void prologue_rows(Frame& F) {
    const float* x = F.in[0]; const float* g0 = F.in[2]; const float* win = F.in[3]; const float* bg = F.in[4];
    bf16* hb = WSP(bf16, WS_HB); float* ss = WSP(float, WS_SS); float* gates = WSP(float, WS_GATES);
    const int gw = blockIdx.x * NWAVES + F.wave, NGW = F.G * NWAVES, lane = F.lane;
    for (int row = gw; row < S; row += NGW) {
        const f32x4* xr = (const f32x4*)(x + (size_t)row * D) + lane; f32x4 v[4]; float s = 0.f;
#pragma unroll
        for (int j = 0; j < 4; ++j) { v[j] = xr[64 * j]; s += (v[j][0] * v[j][0] + v[j][1] * v[j][1]) + (v[j][2] * v[j][2] + v[j][3] * v[j][3]); }
        s = wave_sum(s);
        if (lane < 16) ss[(size_t)row * 16 + lane] = (lane == 0) ? s : 0.f;
        unsigned long long* o8 = (unsigned long long*)(hb + (size_t)row * D) + lane;
#pragma unroll
        for (int j = 0; j < 4; ++j) o8[64 * j] = (unsigned long long)pk2(v[j][0], v[j][1]) | ((unsigned long long)pk2(v[j][2], v[j][3]) << 32);
        float a[8];
#pragma unroll
        for (int k = 0; k < 8; ++k) a[k] = 0.f;
#pragma unroll
        for (int j = 0; j < 4; ++j) { const int d0 = 4 * (lane + 64 * j); const f32x4 gg = *(const f32x4*)(g0 + d0);
#pragma unroll
            for (int e = 0; e < 4; ++e) { const float xv = v[j][e] * gg[e]; const f32x4* wp = (const f32x4*)(win + (size_t)(d0 + e) * ML_IN + 3072); const f32x4 w0 = wp[0], w1 = wp[1];
                a[0] += xv * w0[0]; a[1] += xv * w0[1]; a[2] += xv * w0[2]; a[3] += xv * w0[3]; a[4] += xv * w1[0]; a[5] += xv * w1[1]; a[6] += xv * w1[2]; a[7] += xv * w1[3]; } }
        const float r = 1.0f / sqrtf(s * (1.0f / D) + EPS); float mine = 0.f;
#pragma unroll
        for (int k = 0; k < 8; ++k) { const float t = wave_sum(a[k]); if (lane == k) mine = t; }
        if (lane < 8) gates[(size_t)row * 8 + lane] = mine * r + bg[lane];
    }
    const int* pos = (const int*)F.in[1]; float* rope = WSP(float, WS_ROPE);
    const double inv_rev[8] = {0.15915494309189535, 0.03086376340470123, 0.005985185712713705, 0.001160663641240061, 0.00022507907903927653, 4.364795279280289e-05, 8.464330808241401e-06, 1.6414262627950345e-06};
    for (int idx = blockIdx.x * 512 + F.tid; idx < S * 8; idx += F.G * 512) { const int t = idx >> 3, i = idx & 7;
        double ir = inv_rev[0];
#pragma unroll
        for (int k = 1; k < 8; ++k) ir = (i == k) ? inv_rev[k] : ir;
        const double rev = (double)pos[t] * ir; const float fr = (float)(rev - __builtin_rint(rev));
        rope[(size_t)t * 16 + i] = __builtin_amdgcn_cosf(fr); rope[(size_t)t * 16 + 8 + i] = __builtin_amdgcn_sinf(fr); }
}

__device__ __forceinline__ void ml_chunk_scalars(const float* gates, int c, int hh, int lane, float& b0, float& b1, float& cs0, float& cs1, float& G, float& csmax) {
    const int t0 = c * ML_L + 2 * lane;
    const float f0 = gates[(size_t)t0 * 8 + 4 + hh], f1 = gates[(size_t)(t0 + 1) * 8 + 4 + hh], i0 = gates[(size_t)t0 * 8 + hh], i1 = gates[(size_t)(t0 + 1) * 8 + hh];
    const float l0 = fminf(f0, 0.f) - __logf(1.0f + __expf(-fabsf(f0))), l1 = fminf(f1, 0.f) - __logf(1.0f + __expf(-fabsf(f1)));
    float inc = l0 + l1;
#pragma unroll
    for (int o = 1; o < 64; o <<= 1) { const float t = __shfl_up(inc, o); if (lane >= o) inc += t; }
    b1 = inc; b0 = inc - l1; cs0 = i0 - b0; cs1 = i1 - b1;
    G = __shfl(inc, 63); csmax = wave_max(fmaxf(cs0, cs1));
}
template <int COLS> __device__ __forceinline__ void ml_load_tile(const bf16* g, int gp, LAS unsigned char* tile, int ls, int tid) {
    const int row = tid >> 2, seg = tid & 3; constexpr int PER = COLS / 4;
    const v4u* src = (const v4u*)(g + (size_t)row * gp + seg * PER); LAS v4u* dst = (LAS v4u*)(tile + row * ls + seg * PER * 2);
#pragma unroll
    for (int i = 0; i < PER / 8; ++i) dst[i] = src[i];
}
constexpr int ML_TS = 272;
__device__ __forceinline__ void mlstm_phase_a(Frame& F) {
    const bf16* T0 = WSP(bf16, WS_T0); const bf16* T1 = WSP(bf16, WS_T1); const float* gates = WSP(float, WS_GATES);
    float* Dt = WSP(float, WS_DT); float* nD = WSP(float, WS_ND); float* GA = WSP(float, WS_GA);
    LAS unsigned char* kw = F.lds; LAS unsigned char* vt = F.lds + 34816; constexpr int VS = 528;
    LAS float* wsc = (LAS float*)(F.lds + SCAL_OFF);
    const int tid = F.tid, lane = F.lane, w = F.wave, hi = lane >> 5, qn = lane & 31;
    for (int u = blockIdx.x; u < ML_NC * ML_H; u += F.G) { const int c = u >> 2, hh = u & 3;
        if (w == 0) { float b0, b1, cs0, cs1, G, cm; ml_chunk_scalars(gates, c, hh, lane, b0, b1, cs0, cs1, G, cm);
            wsc[2 * lane] = __expf(cs0 - cm); wsc[2 * lane + 1] = __expf(cs1 - cm);
            if (lane == 0) { GA[(size_t)u * 2] = G; GA[(size_t)u * 2 + 1] = G + cm; } }
        __syncthreads();
        {
            const int row = tid >> 2, seg = tid & 3; const float ws_ = wsc[row];
            const v4u* src = (const v4u*)(T0 + (size_t)(c * ML_L + row) * D + 512 + hh * ML_DK + seg * 32); LAS v4u* dst = (LAS v4u*)(kw + row * ML_TS + seg * 64);
#pragma unroll
            for (int i = 0; i < 4; ++i) { const v4u x = src[i]; v4u y;
                y.x = pk2(bf_lo(x.x) * ws_, bf_hi(x.x) * ws_); y.y = pk2(bf_lo(x.y) * ws_, bf_hi(x.y) * ws_); y.z = pk2(bf_lo(x.z) * ws_, bf_hi(x.z) * ws_); y.w = pk2(bf_lo(x.w) * ws_, bf_hi(x.w) * ws_); dst[i] = y; }
            ml_load_tile<256>(T1 + (size_t)(c * ML_L) * D + hh * ML_DV, D, vt, VS, tid);
        }
        __syncthreads();
        { const int tk = tr_lane_off(lane, ML_TS), tv = tr_lane_off(lane, VS);
          f32x16 acc[4];
#pragma unroll
          for (int i = 0; i < 4; ++i) acc[i] = (f32x16){};
#pragma unroll
          for (int ks = 0; ks < 8; ++ks) { const bf16x8 a = frag_tr_nat(vt, VS, 16 * ks, 32 * w, lane, tv);
#pragma unroll
              for (int dkt = 0; dkt < 4; ++dkt) { const bf16x8 b = frag_tr_nat(kw, ML_TS, 16 * ks, 32 * dkt, lane, tk); acc[dkt] = MFMA32(a, b, acc[dkt]); } }
          float* dst = Dt + (size_t)u * ML_DV * ML_DK;
#pragma unroll
          for (int dkt = 0; dkt < 4; ++dkt)
#pragma unroll
              for (int r = 0; r < 16; ++r) dst[(size_t)(32 * w + crow(r, hi)) * ML_DK + 32 * dkt + qn] = acc[dkt][r];
        }
        if (tid < ML_DK) { float s = 0.f; const LAS bf16* col = (const LAS bf16*)kw + tid;
            for (int r = 0; r < ML_L; ++r) s += __builtin_bit_cast(float, (unsigned)col[r * (ML_TS / 2)] << 16);
            nD[(size_t)u * ML_DK + tid] = s; }
        __syncthreads();
    }
}
__device__ __forceinline__ void mlstm_phase_scan(Frame& F) {
    const float* GA = WSP(float, WS_GA); const float* Dt = WSP(float, WS_DT); const float* nD = WSP(float, WS_ND);
    bf16* Ct = WSP(bf16, WS_CT); float* nst = WSP(float, WS_NST); float* mst = WSP(float, WS_MST);
    LAS float* dec = (LAS float*)F.lds; LAS float* inj = dec + 512;
    if (F.tid < ML_H) { const int hh = F.tid; float m = 0.f;
        for (int c = 0; c < ML_NC; ++c) { const float G = GA[(size_t)(c * 4 + hh) * 2], A = GA[(size_t)(c * 4 + hh) * 2 + 1]; const float mn = fmaxf(G + m, A);
            dec[hh * 128 + c] = __expf(G + m - mn); inj[hh * 128 + c] = __expf(A - mn); if (blockIdx.x == 0) mst[c * 4 + hh] = m; m = mn; } }
    __syncthreads();
    constexpr int NE = ML_H * ML_DV * ML_DK;
    for (int e = blockIdx.x * 512 + F.tid; e < NE; e += F.G * 512) { const int hh = e >> 15, rem = e & 32767; float C = 0.f;
#pragma unroll 8
        for (int c = 0; c < ML_NC; ++c) { const size_t idx = (size_t)(c * 4 + hh) * 32768 + rem; Ct[idx] = (bf16)f2bf(C); C = dec[hh * 128 + c] * C + inj[hh * 128 + c] * Dt[idx]; } }
    for (int e = blockIdx.x * 512 + F.tid; e < ML_H * ML_DK; e += F.G * 512) { const int hh = e >> 7, dk = e & 127; float n = 0.f;
        for (int c = 0; c < ML_NC; ++c) { const size_t idx = (size_t)(c * 4 + hh) * 128 + dk; nst[idx] = n; n = dec[hh * 128 + c] * n + inj[hh * 128 + c] * nD[idx]; } }
    __syncthreads();
}
__device__ __forceinline__ void mlstm_phase_c(Frame& F) {
    const bf16* T0 = WSP(bf16, WS_T0); const bf16* T1 = WSP(bf16, WS_T1); bf16* T2 = WSP(bf16, WS_T2); const float* gates = WSP(float, WS_GATES);
    const bf16* Ct = WSP(bf16, WS_CT); const float* nst = WSP(float, WS_NST); const float* mst = WSP(float, WS_MST); const float* hgain = F.in[5];
    LAS unsigned char* qt = F.lds; LAS unsigned char* kt = F.lds + 34816; LAS unsigned char* vt = F.lds + 2 * 34816; LAS unsigned char* ct = F.lds + 3 * 34816;
    LAS float* sc = (LAS float*)(F.lds + SCAL_OFF);
    LAS float* sM = sc, * sCS = sc + 128, * sWI = sc + 256, * sEM = sc + 384, * sNV = sc + 512, * sQN = sc + 640, * sDS = sc + 768  , * sSQ = sc + 1024  ;
    const int tid = F.tid, lane = F.lane, w = F.wave, hi = lane >> 5, qn = lane & 31, tb = w & 3, wh = w >> 2;
    const int trv = tr_lane_off(lane, ML_TS);
    for (int u = blockIdx.x; u < ML_NC * ML_H; u += F.G) { const int c = u >> 2, hh = u & 3; const int tok0 = c * ML_L;
        if (w == 0) { float b0, b1, cs0, cs1, G, cm; ml_chunk_scalars(gates, c, hh, lane, b0, b1, cs0, cs1, G, cm);
            const float mc = mst[u]; float inc = fmaxf(cs0, cs1);
#pragma unroll
            for (int o = 1; o < 64; o <<= 1) { const float t = __shfl_up(inc, o); if (lane >= o) inc = fmaxf(inc, t); }
            float ex = __shfl_up(inc, 1); if (lane == 0) ex = -3.0e38f;
            const float M0 = fmaxf(mc, fmaxf(ex, cs0)), M1 = fmaxf(mc, inc);
            sM[2 * lane] = M0; sM[2 * lane + 1] = M1; sCS[2 * lane] = cs0; sCS[2 * lane + 1] = cs1;
            sWI[2 * lane] = __expf(mc - M0); sWI[2 * lane + 1] = __expf(mc - M1); sEM[2 * lane] = __expf(-(b0 + M0)); sEM[2 * lane + 1] = __expf(-(b1 + M1)); }
        if (tid >= 64 && tid < 64 + ML_DK) sNV[tid - 64] = nst[(size_t)u * ML_DK + (tid - 64)];
        ml_load_tile<128>(T0 + (size_t)tok0 * D + hh * ML_DK, D, qt, ML_TS, tid);
        ml_load_tile<128>(T0 + (size_t)tok0 * D + 512 + hh * ML_DK, D, kt, ML_TS, tid);
        __syncthreads();
        const int t = 32 * tb + qn; const float Mt = sM[t]; float rowsum = 0.f; v2u pp[2][4];
#pragma unroll
        for (int i = 0; i < 2; ++i) { const int st = 2 * wh + i;
#pragma unroll
            for (int g = 0; g < 4; ++g) pp[i][g] = (v2u){0u, 0u};
            if (st <= tb) { f32x16 a = {};
#pragma unroll
                for (int ks = 0; ks < 8; ++ks) a = MFMA32(frag_row(kt, ML_TS, 32 * st, 16 * ks, lane), frag_row(qt, ML_TS, 32 * tb, 16 * ks, lane), a);
#pragma unroll
                for (int r = 0; r < 16; ++r) { const int s = 32 * st + crow(r, hi); const float wg = (s <= t) ? __expf(sCS[s] - Mt) : 0.f; a[r] *= wg; rowsum += a[r]; }
#pragma unroll
                for (int g = 0; g < 4; ++g) pp[i][g] = (v2u){pk2(a[4 * g], a[4 * g + 1]), pk2(a[4 * g + 2], a[4 * g + 3])}; } }
        rowsum += __shfl_xor(rowsum, 32);
        if (hi == 0) sDS[wh * 128 + t] = rowsum;
        __syncthreads();
        { LAS unsigned char* P = kt;
#pragma unroll
          for (int i = 0; i < 2; ++i)
#pragma unroll
              for (int g = 0; g < 4; ++g) *(LAS v2u*)(P + t * ML_TS + (32 * (2 * wh + i) + 8 * g + 4 * hi) * 2) = pp[i][g]; }
        if (tid < ML_L) { float s = 0.f; const LAS bf16* qr = (const LAS bf16*)(qt + tid * ML_TS);
            for (int d = 0; d < ML_DK; ++d) s += __builtin_bit_cast(float, (unsigned)qr[d] << 16) * sNV[d];
            sQN[tid] = s; }
        __syncthreads();
        { const int row = tid >> 2, seg = tid & 3; const float wi = sWI[row]; LAS v4u* p = (LAS v4u*)(qt + row * ML_TS + seg * 64);
#pragma unroll
          for (int i = 0; i < 4; ++i) { const v4u x = p[i]; v4u y; y.x = pk2(bf_lo(x.x) * wi, bf_hi(x.x) * wi); y.y = pk2(bf_lo(x.y) * wi, bf_hi(x.y) * wi); y.z = pk2(bf_lo(x.z) * wi, bf_hi(x.z) * wi); y.w = pk2(bf_lo(x.w) * wi, bf_hi(x.w) * wi); p[i] = y; } }
        f32x16 num[2][2];
#pragma unroll
        for (int hf = 0; hf < 2; ++hf) {
            if (hf) __syncthreads();
            ml_load_tile<128>(T1 + (size_t)tok0 * D + hh * ML_DV + 128 * hf, D, vt, ML_TS, tid);
            ml_load_tile<128>(Ct + (size_t)u * 32768 + (size_t)(128 * hf) * ML_DK, ML_DK, ct, ML_TS, tid);
            __syncthreads();
            num[hf][0] = (f32x16){}; num[hf][1] = (f32x16){};
            for (int ks = 0; ks < 2 * (tb + 1); ++ks) { const bf16x8 b = frag_row(kt, ML_TS, 32 * tb, 16 * ks, lane);
#pragma unroll
                for (int i = 0; i < 2; ++i) num[hf][i] = MFMA32(frag_tr_nat(vt, ML_TS, 16 * ks, 32 * (2 * wh + i), lane, trv), b, num[hf][i]); }
#pragma unroll
            for (int ks = 0; ks < 8; ++ks) { const bf16x8 b = frag_row(qt, ML_TS, 32 * tb, 16 * ks, lane);
#pragma unroll
                for (int i = 0; i < 2; ++i) num[hf][i] = MFMA32(frag_row(ct, ML_TS, 32 * (2 * wh + i), 16 * ks, lane), b, num[hf][i]); }
        }
        float den = sDS[t] + sDS[128 + t] + sWI[t] * sQN[t]; den = fmaxf(fabsf(den), sEM[t]); const float inv = 1.0f / den; float sq = 0.f;
#pragma unroll
        for (int hf = 0; hf < 2; ++hf)
#pragma unroll
            for (int i = 0; i < 2; ++i)
#pragma unroll
                for (int r = 0; r < 16; ++r) { num[hf][i][r] *= inv; sq += num[hf][i][r] * num[hf][i][r]; }
        sq += __shfl_xor(sq, 32);
        if (hi == 0) sSQ[wh * 128 + t] = sq;
        __syncthreads();
        const float rinv = 1.0f / sqrtf((sSQ[t] + sSQ[128 + t]) * (1.0f / ML_DV) + EPS);
#pragma unroll
        for (int hf = 0; hf < 2; ++hf)
#pragma unroll
            for (int i = 0; i < 2; ++i)
#pragma unroll
                for (int g = 0; g < 4; ++g) { const int col = hh * ML_DV + 128 * hf + 32 * (2 * wh + i) + 8 * g + 4 * hi; bf16* op = T2 + (size_t)(tok0 + t) * D + col;
                    const v2u ow = *(const v2u*)op; const f32x4 hg = *(const f32x4*)(hgain + col);
                    const float o0 = bf_lo(ow.x), o1 = bf_hi(ow.x), o2 = bf_lo(ow.y), o3 = bf_hi(ow.y);
                    const float y0 = num[hf][i][4 * g] * rinv * hg[0] * __builtin_amdgcn_rcpf(1.0f + __expf(-o0)), y1 = num[hf][i][4 * g + 1] * rinv * hg[1] * __builtin_amdgcn_rcpf(1.0f + __expf(-o1));
                    const float y2 = num[hf][i][4 * g + 2] * rinv * hg[2] * __builtin_amdgcn_rcpf(1.0f + __expf(-o2)), y3 = num[hf][i][4 * g + 3] * rinv * hg[3] * __builtin_amdgcn_rcpf(1.0f + __expf(-o3));
                    *(v2u*)op = (v2u){pk2(y0, y1), pk2(y2, y3)}; }
        __syncthreads();
    }
}

constexpr int KT_S = 144, VT_S = 192;
constexpr int MB_VT_OFF = 256 * KT_S;
__device__ __forceinline__ int list_base(int h, int j) { return h * LIST_HEAD_CAP + 256 * (63 * j - (j * (j - 1)) / 2); }
__device__ __forceinline__ void mb_load_kv(const bf16* Kg, const bf16* Vg, int j, int h, LAS unsigned char* lds, int tid) {
    const int row = tid >> 1, half = tid & 1; const size_t go = (size_t)(j * MB_BLK + row) * D + h * DH + half * 32;
    const v4u* ks = (const v4u*)(Kg + go); const v4u* vs = (const v4u*)(Vg + go);
    LAS v4u* kd = (LAS v4u*)(lds + row * KT_S + half * 64); LAS v4u* vd = (LAS v4u*)(lds + MB_VT_OFF + row * VT_S + half * 64);
#pragma unroll
    for (int i = 0; i < 4; ++i) { kd[i] = ks[i]; vd[i] = vs[i]; }
}
template <bool CAUSAL> __device__ __forceinline__ void mb_attend(LAS const unsigned char* kt, LAS const unsigned char* vt, const bf16x8 (&qf)[4], int nkb, int lane, f32x16& o0, f32x16& o1, float& m, float& lsum) {
    const int hi = lane >> 5, qn = lane & 31, trv = tr_lane_off(lane, VT_S);
    o0 = (f32x16){}; o1 = (f32x16){}; m = -1.0e30f; lsum = 0.f;
    for (int kb = 0; kb < nkb; ++kb) {
        f32x16 st = {};
#pragma unroll
        for (int s = 0; s < 4; ++s) st = MFMA32(frag_row(kt, KT_S, 32 * kb, 16 * s, lane), qf[s], st);
        if (CAUSAL) { if (kb == nkb - 1) {
#pragma unroll
            for (int r = 0; r < 16; ++r) if (crow(r, hi) > qn) st[r] = -1.0e30f; } }
        float mb = st[0];
#pragma unroll
        for (int r = 1; r < 16; ++r) mb = fmaxf(mb, st[r]);
        mb = fmaxf(mb, __shfl_xor(mb, 32));
        const float mn = fmaxf(m, mb), alpha = ex2(m - mn); m = mn; float ps = 0.f;
#pragma unroll
        for (int r = 0; r < 16; ++r) { st[r] = ex2(st[r] - mn); ps += st[r]; }
        lsum = lsum * alpha + ps; o0 *= alpha; o1 *= alpha;
#pragma unroll
        for (int s2 = 0; s2 < 2; ++s2) { const bf16x8 pf = pack_acc(st, s2);
            o0 = MFMA32(frag_tr_acc(vt, VT_S, 32 * kb + 16 * s2, 0, lane, trv), pf, o0);
            o1 = MFMA32(frag_tr_acc(vt, VT_S, 32 * kb + 16 * s2, 32, lane, trv), pf, o1); }
    }
}
__device__ __forceinline__ void moba_kmean(Frame& F) {
    const bf16* Kg = WSP(bf16, WS_T1); float* km = WSP(float, WS_KMEAN); LAS float* red = (LAS float*)(F.lds + AUX_OFF);
    const int tid = F.tid, rg = tid >> 3, cg = tid & 7;
    for (int u = blockIdx.x; u < NHEAD * MB_NB; u += F.G) { const int h = u >> 6, j = u & 63; float a[8];
#pragma unroll
        for (int e = 0; e < 8; ++e) a[e] = 0.f;
#pragma unroll
        for (int i = 0; i < 4; ++i) { const v4u x = *(const v4u*)(Kg + (size_t)(j * MB_BLK + rg * 4 + i) * D + h * DH + cg * 8);
            a[0] += bf_lo(x.x); a[1] += bf_hi(x.x); a[2] += bf_lo(x.y); a[3] += bf_hi(x.y); a[4] += bf_lo(x.z); a[5] += bf_hi(x.z); a[6] += bf_lo(x.w); a[7] += bf_hi(x.w); }
#pragma unroll
        for (int e = 0; e < 8; ++e) red[rg * 65 + cg * 8 + e] = a[e];
        __syncthreads();
        if (tid < 64) { float s = 0.f; for (int r = 0; r < 64; ++r) s += red[r * 65 + tid]; km[(size_t)u * 64 + tid] = s * (1.0f / 256.0f); }
        __syncthreads();
    }
}
__device__ __forceinline__ void moba_route(Frame& F) {
    const bf16* Qg = WSP(bf16, WS_T0); const float* km = WSP(float, WS_KMEAN); unsigned* sel = WSP(unsigned, WS_SEL); float* lse = WSP(float, WS_LSE);
    LAS float* kml = (LAS float*)F.lds;
    const int tid = F.tid;
    for (int u = blockIdx.x; u < NHEAD * (S / 512); u += F.G) { const int h = u >> 5, t = (u & 31) * 512 + tid;
        __syncthreads();
        for (int i = tid; i < 1024; i += 512) ((LAS f32x4*)kml)[i] = ((const f32x4*)(km + (size_t)h * 4096))[i];
        __syncthreads();
        float q[64];
#pragma unroll
        for (int i = 0; i < 8; ++i) { const v4u x = *(const v4u*)(Qg + (size_t)t * D + h * DH + 8 * i);
            q[8 * i] = bf_lo(x.x); q[8 * i + 1] = bf_hi(x.x); q[8 * i + 2] = bf_lo(x.y); q[8 * i + 3] = bf_hi(x.y); q[8 * i + 4] = bf_lo(x.z); q[8 * i + 5] = bf_hi(x.z); q[8 * i + 6] = bf_lo(x.w); q[8 * i + 7] = bf_hi(x.w); }
        const int cur = __builtin_amdgcn_readfirstlane(t >> 8);
        float v0 = -3.0e38f, v1 = -3.0e38f, v2 = -3.0e38f; int i0 = 255, i1 = 255, i2 = 255;
        for (int j = 0; j < cur; ++j) { const LAS f32x4* kr = (const LAS f32x4*)(kml + j * 64); float g0 = 0.f, g1 = 0.f;
#pragma unroll
            for (int i = 0; i < 16; i += 2) { const f32x4 ka = kr[i], kb = kr[i + 1];
                g0 += q[4 * i] * ka[0] + q[4 * i + 1] * ka[1] + q[4 * i + 2] * ka[2] + q[4 * i + 3] * ka[3];
                g1 += q[4 * i + 4] * kb[0] + q[4 * i + 5] * kb[1] + q[4 * i + 6] * kb[2] + q[4 * i + 7] * kb[3]; }
            const float g = g0 + g1;
            if (g > v0) { v2 = v1; i2 = i1; v1 = v0; i1 = i0; v0 = g; i0 = j; }
            else if (g > v1) { v2 = v1; i2 = i1; v1 = g; i1 = j; }
            else if (g > v2) { v2 = g; i2 = j; } }
        sel[(size_t)h * S + t] = (unsigned)i0 | ((unsigned)i1 << 8) | ((unsigned)i2 << 16);
        *(f32x4*)(lse + ((size_t)t * NHEAD + h) * 4) = (f32x4){-1.0e30f, -1.0e30f, -1.0e30f, -1.0e30f};
    }
}
__device__ __forceinline__ void moba_buckets(Frame& F) {
    const unsigned* sel = WSP(unsigned, WS_SEL); unsigned short* list = WSP(unsigned short, WS_LIST); int* cnt = WSP(int, WS_CNT);
    LAS int* wcnt = (LAS int*)F.lds;
    const int tid = F.tid, lane = F.lane, w = F.wave;
    for (int u = blockIdx.x; u < NHEAD * MB_NB; u += F.G) { const int h = u >> 6, j = u & 63; const int base = list_base(h, j); int count = 0;
        for (int q0 = (j + 1) * MB_BLK; q0 < S; q0 += 512) { const int q = q0 + tid; int slot = -1;
            if (q < S) { const unsigned sv = sel[(size_t)h * S + q]; slot = ((int)(sv & 255u) == j) ? 0 : ((int)((sv >> 8) & 255u) == j) ? 1 : ((int)((sv >> 16) & 255u) == j) ? 2 : -1; }
            const unsigned long long bal = __ballot(slot >= 0); const int before = __builtin_popcountll(bal & ((1ull << lane) - 1ull));
            if (lane == 0) wcnt[w] = __builtin_popcountll(bal);
            __syncthreads();
            int off = 0, tot = 0;
#pragma unroll
            for (int k = 0; k < 8; ++k) { const int ck = wcnt[k]; off += (k < w) ? ck : 0; tot += ck; }
            if (slot >= 0) list[(size_t)base + count + off + before] = (unsigned short)(q | (slot << 14));
            count += tot;
            __syncthreads(); }
        if (tid == 0) cnt[u] = count;
    }
}
__device__ __forceinline__ void moba_selected(Frame& F) {
    const bf16* Qg = WSP(bf16, WS_T0); const bf16* Kg = WSP(bf16, WS_T1); const bf16* Vg = WSP(bf16, WS_T2);
    const unsigned short* list = WSP(unsigned short, WS_LIST); const int* cnt = WSP(int, WS_CNT); bf16* po = WSP(bf16, WS_PO); float* lse = WSP(float, WS_LSE);
    LAS int* pre = (LAS int*)(F.lds + 98304);
    const int tid = F.tid, lane = F.lane, w = F.wave, hi = lane >> 5, qn = lane & 31;
    {
        if (w == 0) { int loc[16]; int s = 0;
#pragma unroll
            for (int i = 0; i < 16; ++i) { loc[i] = (cnt[lane * 16 + i] + 255) >> 8; s += loc[i]; }
            int inc = s;
#pragma unroll
            for (int o = 1; o < 64; o <<= 1) { const int t = __shfl_up(inc, o); if (lane >= o) inc += t; }
            int run = inc - s;
#pragma unroll
            for (int i = 0; i < 16; ++i) { pre[lane * 16 + i] = run; run += loc[i]; }
            if (lane == 63) pre[1024] = run; }
        __syncthreads(); }
    const int nitems = pre[1024];
    for (int it = blockIdx.x; it < nitems; it += F.G) {
        int lo = 0, hb_ = 1024;
        while (hb_ - lo > 1) { const int mid = (lo + hb_) >> 1; if (pre[mid] <= it) lo = mid; else hb_ = mid; }
        const int b = lo, h = b >> 6, j = b & 63, chunk = it - pre[b]; const int n = cnt[b], nq = min(256, n - chunk * 256); const int lb = list_base(h, j) + chunk * 256;
        mb_load_kv(Kg, Vg, j, h, F.lds, tid);
        __syncthreads();
        if (32 * w < nq) { const bool valid = (32 * w + qn) < nq; const unsigned e = list[(size_t)lb + (valid ? 32 * w + qn : 0)]; const int q = e & 0x3fff, slot = e >> 14;
            bf16x8 qf[4]; const bf16* qp = Qg + (size_t)q * D + h * DH + 8 * hi;
#pragma unroll
            for (int s = 0; s < 4; ++s) qf[s] = *(const bf16x8*)(qp + 16 * s);
            f32x16 o0, o1; float m, ls;
            mb_attend<false>(F.lds, F.lds + MB_VT_OFF, qf, 8, lane, o0, o1, m, ls);
            ls += __shfl_xor(ls, 32); const float inv = 1.0f / ls;
            if (valid) { bf16* op = po + (size_t)slot * S * D + (size_t)q * D + h * DH + 4 * hi;
#pragma unroll
                for (int g = 0; g < 4; ++g) { *(v2u*)(op + 8 * g) = (v2u){pk2(o0[4 * g] * inv, o0[4 * g + 1] * inv), pk2(o0[4 * g + 2] * inv, o0[4 * g + 3] * inv)};
                                              *(v2u*)(op + 32 + 8 * g) = (v2u){pk2(o1[4 * g] * inv, o1[4 * g + 1] * inv), pk2(o1[4 * g + 2] * inv, o1[4 * g + 3] * inv)}; }
                if (hi == 0) lse[((size_t)q * NHEAD + h) * 4 + slot] = m + lg2(ls); } }
        __syncthreads();
    }
}
__device__ __forceinline__ void moba_own_merge(Frame& F) {
    bf16* Qg = WSP(bf16, WS_T0); const bf16* Kg = WSP(bf16, WS_T1); const bf16* Vg = WSP(bf16, WS_T2); const bf16* po = WSP(bf16, WS_PO); const float* lse = WSP(float, WS_LSE);
    const int tid = F.tid, lane = F.lane, w = F.wave, hi = lane >> 5, qn = lane & 31;
    for (int u = blockIdx.x; u < NHEAD * MB_NB; u += F.G) { const int h = u & 15, j = u >> 4;
        mb_load_kv(Kg, Vg, j, h, F.lds, tid);
        __syncthreads();
        const int t = j * MB_BLK + 32 * w + qn; bf16* qp = Qg + (size_t)t * D + h * DH;
        bf16x8 qf[4];
#pragma unroll
        for (int s = 0; s < 4; ++s) qf[s] = *(const bf16x8*)(qp + 8 * hi + 16 * s);
        f32x16 o0, o1; float m, ls;
        mb_attend<true>(F.lds, F.lds + MB_VT_OFF, qf, w + 1, lane, o0, o1, m, ls);
        ls += __shfl_xor(ls, 32);
        const float lown = m + lg2(ls); const f32x4 lw = *(const f32x4*)(lse + ((size_t)t * NHEAD + h) * 4);
        const float W = fmaxf(fmaxf(lown, lw[0]), fmaxf(lw[1], lw[2]));
        const float cown = ex2(lown - W); float cs[3];
#pragma unroll
        for (int s = 0; s < 3; ++s) cs[s] = (lw[s] > -1.0e29f) ? ex2(lw[s] - W) : 0.f;
        const float rden = 1.0f / (cown + cs[0] + cs[1] + cs[2]); const float co = cown * rden / ls;
        o0 *= co; o1 *= co;
#pragma unroll
        for (int s = 0; s < 3; ++s) if (cs[s] != 0.f) { const float c_ = cs[s] * rden; const bf16* pp = po + (size_t)s * S * D + (size_t)t * D + h * DH + 4 * hi;
#pragma unroll
            for (int g = 0; g < 4; ++g) { const v2u a = *(const v2u*)(pp + 8 * g), b = *(const v2u*)(pp + 32 + 8 * g);
                o0[4 * g] += c_ * bf_lo(a.x); o0[4 * g + 1] += c_ * bf_hi(a.x); o0[4 * g + 2] += c_ * bf_lo(a.y); o0[4 * g + 3] += c_ * bf_hi(a.y);
                o1[4 * g] += c_ * bf_lo(b.x); o1[4 * g + 1] += c_ * bf_hi(b.x); o1[4 * g + 2] += c_ * bf_lo(b.y); o1[4 * g + 3] += c_ * bf_hi(b.y); } }
#pragma unroll
        for (int g = 0; g < 4; ++g) { *(v2u*)(qp + 4 * hi + 8 * g) = (v2u){pk2(o0[4 * g], o0[4 * g + 1]), pk2(o0[4 * g + 2], o0[4 * g + 3])};
                                      *(v2u*)(qp + 4 * hi + 32 + 8 * g) = (v2u){pk2(o1[4 * g], o1[4 * g + 1]), pk2(o1[4 * g + 2], o1[4 * g + 3])}; }
        __syncthreads();
    }
}

__device__ __forceinline__ void ld8(const bf16* p, float (&o)[8]) { const v4u x = *(const v4u*)p; o[0] = bf_lo(x.x); o[1] = bf_hi(x.x); o[2] = bf_lo(x.y); o[3] = bf_hi(x.y); o[4] = bf_lo(x.z); o[5] = bf_hi(x.z); o[6] = bf_lo(x.w); o[7] = bf_hi(x.w); }
__device__ __forceinline__ void conv_phase(Frame& F) {
    bf16* Bg = WSP(bf16, WS_T0); const bf16* Zg = WSP(bf16, WS_T1); const float* cw = F.in[10];
    const int tid = F.tid, cg = tid & 127, rp = tid >> 7;
    float w0[8], w1[8], w2[8];
#pragma unroll
    for (int e = 0; e < 8; ++e) { w0[e] = cw[cg * 8 + e]; w1[e] = cw[D + cg * 8 + e]; w2[e] = cw[2 * D + cg * 8 + e]; }
    for (int u = blockIdx.x; u < S / 64; u += F.G) { const int r0 = u * 64 + rp * 16; float zm2[8], zm1[8];
        if (r0 >= 2) { ld8(Zg + (size_t)(r0 - 2) * D + cg * 8, zm2); ld8(Zg + (size_t)(r0 - 1) * D + cg * 8, zm1); }
        else {
#pragma unroll
            for (int e = 0; e < 8; ++e) { zm2[e] = 0.f; zm1[e] = 0.f; } }
#pragma unroll 4
        for (int r = r0; r < r0 + 16; ++r) { float z[8], b[8], y[8]; ld8(Zg + (size_t)r * D + cg * 8, z); ld8(Bg + (size_t)r * D + cg * 8, b);
#pragma unroll
            for (int e = 0; e < 8; ++e) { y[e] = b[e] * (w0[e] * zm2[e] + w1[e] * zm1[e] + w2[e] * z[e]); zm2[e] = zm1[e]; zm1[e] = z[e]; }
            *(v4u*)(Bg + (size_t)r * D + cg * 8) = (v4u){pk2(y[0], y[1]), pk2(y[2], y[3]), pk2(y[4], y[5]), pk2(y[6], y[7])}; }
    }
}

constexpr float SB_STOP = 151.0f;
__device__ __forceinline__ void sb_phase(Frame& F) {
    bf16* Qg = WSP(bf16, WS_T0); const bf16* Kg = WSP(bf16, WS_T1); const bf16* Vg = WSP(bf16, WS_T2);
    const int lane = F.lane, hi = lane >> 5, qn = lane & 31;
    LAS unsigned char* vt = F.lds + AUX_OFF + F.wave * 6144;
    const int trv = tr_lane_off(lane, VT_S);
    for (int u = blockIdx.x * NWAVES + F.wave; u < NHEAD * (S / 32); u += F.G * NWAVES) { const int head = u & 15, qb = u >> 4, t = qb * 32 + qn;
        bf16* qp = Qg + (size_t)t * D + head * DH; bf16x8 qf[4];
#pragma unroll
        for (int s = 0; s < 4; ++s) qf[s] = *(const bf16x8*)(qp + 8 * hi + 16 * s);
        f32x16 o0 = {}, o1 = {}; float R = 0.f;
        for (int kb = qb; kb >= 0; --kb) { const int k0 = kb * 32;
            const bf16* kp = Kg + (size_t)(k0 + qn) * D + head * DH + 8 * hi; bf16x8 kf[4];
#pragma unroll
            for (int s = 0; s < 4; ++s) kf[s] = *(const bf16x8*)(kp + 16 * s);
            { const v4u* vs = (const v4u*)(Vg + (size_t)(k0 + (lane >> 1)) * D + head * DH + 32 * (lane & 1)); LAS v4u* vd = (LAS v4u*)(vt + (lane >> 1) * VT_S + (lane & 1) * 64);
#pragma unroll
              for (int i = 0; i < 4; ++i) vd[i] = vs[i]; }
            f32x16 st = {};
#pragma unroll
            for (int s = 0; s < 4; ++s) st = MFMA32(kf[s], qf[s], st);
            const bool diag = (kb == qb); float sp[16];
#pragma unroll
            for (int r = 0; r < 16; ++r) { const float z = st[r]; const float e = ex2(z); float v = (z > 30.f) ? z : lg2(1.0f + e); if (diag && crow(r, hi) >= qn) v = 0.f; sp[r] = v; }
            float ina[16], gt[4], pg[4];
#pragma unroll
            for (int g = 0; g < 4; ++g) { const float s3 = sp[4 * g + 3], s2 = sp[4 * g + 2] + s3, s1 = sp[4 * g + 1] + s2, s0 = sp[4 * g] + s1;
                ina[4 * g + 3] = 0.f; ina[4 * g + 2] = s3; ina[4 * g + 1] = s2; ina[4 * g] = s1; gt[g] = s0; }
#pragma unroll
            for (int g = 0; g < 4; ++g) pg[g] = __shfl_xor(gt[g], 32);
            float tail = 0.f, later[4];
#pragma unroll
            for (int g = 3; g >= 0; --g) { const float lo_ = hi ? pg[g] : gt[g], hi_ = hi ? gt[g] : pg[g]; later[g] = hi ? tail : (hi_ + tail); tail += lo_ + hi_; }
#pragma unroll
            for (int r = 0; r < 16; ++r) { const float a = ex2(st[r] - sp[r] - (R + later[r >> 2] + ina[r])); st[r] = (diag && crow(r, hi) >= qn) ? 0.f : a; }
            R += tail;
#pragma unroll
            for (int s2 = 0; s2 < 2; ++s2) { const bf16x8 pf = pack_acc(st, s2);
                o0 = MFMA32(frag_tr_acc(vt, VT_S, 16 * s2, 0, lane, trv), pf, o0);
                o1 = MFMA32(frag_tr_acc(vt, VT_S, 16 * s2, 32, lane, trv), pf, o1); }
            if (__all(R > SB_STOP)) break;
        }
#pragma unroll
        for (int g = 0; g < 4; ++g) { *(v2u*)(qp + 4 * hi + 8 * g) = (v2u){pk2(o0[4 * g], o0[4 * g + 1]), pk2(o0[4 * g + 2], o0[4 * g + 3])};
                                      *(v2u*)(qp + 4 * hi + 32 + 8 * g) = (v2u){pk2(o1[4 * g], o1[4 * g + 1]), pk2(o1[4 * g + 2], o1[4 * g + 3])}; }
    }
}

__device__ __forceinline__ void final_norm(Frame& F) {
    float* h = F.out; const float* ss = WSP(float, WS_SS); const float* fg = F.in[17];
    const int gw = blockIdx.x * NWAVES + F.wave, NGW = F.G * NWAVES, lane = F.lane;
    for (int row = gw; row < S; row += NGW) { const float rs = pg8::row_rs(ss, row); f32x4* hr = (f32x4*)(h + (size_t)row * D) + lane;
#pragma unroll
        for (int j = 0; j < 4; ++j) { const f32x4 g = *((const f32x4*)fg + lane + 64 * j); hr[64 * j] = hr[64 * j] * rs * g; } }
}

struct Args { const float* in[18]; float* out; unsigned char* ws; int ph_lo, ph_hi; };
__global__ void __launch_bounds__(NWAVES * 64, 2) hybrid_fwd(Args args) {
    extern __shared__ __attribute__((aligned(16))) unsigned char lds[];
    Frame F;
    F.lds = (LAS unsigned char*)lds;
    F.MISC = (volatile LAS unsigned*)(F.lds + MISC_OFF);
    F.tid = threadIdx.x; F.lane = F.tid & 63; F.wave = __builtin_amdgcn_readfirstlane(F.tid >> 6);
    F.G = gridDim.x; F.ws = args.ws; F.out = args.out;
#pragma unroll
    for (int i = 0; i < 18; ++i) F.in[i] = args.in[i];
    F.ctl = (gu32*)(args.ws + WS_CTL);
    for (int u = F.tid; u < (LDS_BYTES - MISC_OFF) / 4; u += NWAVES * 64) ((LAS unsigned*)(F.lds + MISC_OFF))[u] = 0u;
    __syncthreads();
    XcdBarrier bar; bar.bar = (unsigned*)(F.ctl + CW_BAR); bar.x = 0; bar.st = nullptr;
    if (!MK_PER_PHASE) bar = xcd_barrier_post((unsigned*)(F.ctl + CW_BAR), F.MISC + 8);
    const int lo = args.ph_lo, hi = args.ph_hi;
#define IN(k) (lo <= (k) && (k) < hi)
#define SEAM(k) do { if (IN(k) && IN((k) + 1)) xcd_barrier(bar); } while (0)
    bf16* const T0 = WSP(bf16, WS_T0); bf16* const T2 = WSP(bf16, WS_T2); bf16* const HB = WSP(bf16, WS_HB); float* const SS = WSP(float, WS_SS); const float* const ROPE = WSP(float, WS_ROPE);
    bf16* const WIN = WSP(bf16, WS_WIN); bf16* const WOUT = WSP(bf16, WS_WOUT); bf16* const WGU = WSP(bf16, WS_WGU); bf16* const WD = WSP(bf16, WS_WD);
    LAS unsigned char* const ring = F.lds;
#define GEMM_IN(MODE, NSC, SC0) do { pg8::Gemm g{HB, WIN, S, 3 * D, D}; pg8::StaticOrder So; So.init(S, 3 * D, F.G, (int)blockIdx.x); \
        pg8::EpiIn<MODE> E{T0, SS, ROPE, (NSC), (SC0)}; pg8::gemm_phase<pg8::EpiIn<MODE>, pg8::StaticOrder, true, true>(ring, g, So, E); } while (0)
#define GEMM_OUT(APTR, RES) do { pg8::Gemm g{(APTR), WOUT, S, D, D}; pg8::StaticOrder So; So.init(S, D, F.G, (int)blockIdx.x); \
        pg8::EpiRes E{(RES), F.out, HB, SS}; pg8::gemm_phase<pg8::EpiRes, pg8::StaticOrder, false, true>(ring, g, So, E); } while (0)
#define GEMM_UP() do { pg8::Gemm g{HB, WGU, S, 2 * FF, D}; pg8::StaticOrder So; So.init(S, 2 * FF, F.G, (int)blockIdx.x); \
        pg8::EpiGlu E{T0, FF, SS}; pg8::gemm_phase<pg8::EpiGlu, pg8::StaticOrder, true, true>(ring, g, So, E); } while (0)
#define GEMM_DOWN() do { pg8::Gemm g{T0, WD, S, D, FF}; pg8::StaticOrder So; So.init(S, D, F.G, (int)blockIdx.x); \
        pg8::EpiRes E{F.out, F.out, HB, SS}; pg8::gemm_phase<pg8::EpiRes, pg8::StaticOrder, false, true>(ring, g, So, E); } while (0)

    if (IN(0)) { convert_win(F, 0); convert_rest(F, 0); prologue_rows(F); } SEAM(0);
    if (IN(1)) { GEMM_IN(0, 2, 0.08838834764831845f); } SEAM(1);
    if (IN(2)) { convert_win(F, 1); __syncthreads(); mlstm_phase_a(F); } SEAM(2);
    if (IN(3)) { mlstm_phase_scan(F); } SEAM(3);
    if (IN(4)) { mlstm_phase_c(F); } SEAM(4);
    if (IN(5)) { GEMM_OUT(T2, F.in[0]); } SEAM(5);
    if (IN(6)) { GEMM_UP(); } SEAM(6);
    if (IN(7)) { GEMM_DOWN(); } SEAM(7);
    if (IN(8)) { GEMM_IN(1, 4, C2); } SEAM(8);
    if (IN(9)) { convert_rest(F, 1); convert_win(F, 2); __syncthreads(); moba_kmean(F); } SEAM(9);
    if (IN(10)) { moba_route(F); } SEAM(10);
    if (IN(11)) { moba_buckets(F); } SEAM(11);
    if (IN(12)) { moba_selected(F); } SEAM(12);
    if (IN(13)) { moba_own_merge(F); } SEAM(13);
    if (IN(14)) { GEMM_OUT(T0, F.out); } SEAM(14);
    if (IN(15)) { GEMM_UP(); } SEAM(15);
    if (IN(16)) { GEMM_DOWN(); } SEAM(16);
    if (IN(17)) { GEMM_IN(2, 0, 1.0f); } SEAM(17);
    if (IN(18)) { convert_rest(F, 2); convert_win(F, 3); __syncthreads(); conv_phase(F); } SEAM(18);
    if (IN(19)) { GEMM_OUT(T0, F.out); } SEAM(19);
    if (IN(20)) { GEMM_UP(); } SEAM(20);
    if (IN(21)) { GEMM_DOWN(); } SEAM(21);
    if (IN(22)) { GEMM_IN(0, 4, C2); } SEAM(22);
    if (IN(23)) { convert_rest(F, 3); __syncthreads(); sb_phase(F); } SEAM(23);
    if (IN(24)) { GEMM_OUT(T0, F.out); } SEAM(24);
    if (IN(25)) { GEMM_UP(); } SEAM(25);
    if (IN(26)) { GEMM_DOWN(); } SEAM(26);
    if (IN(27)) { final_norm(F); }
#undef IN
#undef SEAM
}

extern "C" void kernel_launch(void* const* d_in, const int* in_sizes, int n_in, void* d_out, int out_size, void* d_ws, size_t ws_size, hipStream_t stream) {
    static int grid = 0;
    if (grid == 0) {
        if (n_in != 18 || out_size != S * D || ws_size < WS_END) { fprintf(stderr, "kernel_launch: unexpected shapes (n_in %d, out %d, ws %zu)\n", n_in, out_size, ws_size); grid = -1; return; }
        int dev = 0, cus = 0, per_cu = 0;
        if (hipGetDevice(&dev) != hipSuccess || hipDeviceGetAttribute(&cus, hipDeviceAttributeMultiprocessorCount, dev) != hipSuccess) { grid = -1; return; }
        if (hipFuncSetAttribute((const void*)hybrid_fwd, hipFuncAttributeMaxDynamicSharedMemorySize, LDS_BYTES) != hipSuccess) { fprintf(stderr, "kernel_launch: hipFuncSetAttribute failed\n"); grid = -1; return; }
        if (hipOccupancyMaxActiveBlocksPerMultiprocessor(&per_cu, (const void*)hybrid_fwd, NWAVES * 64, LDS_BYTES) != hipSuccess || per_cu < 1) { fprintf(stderr, "kernel_launch: occupancy query says %d blocks per CU\n", per_cu); }
        (void)hipGetLastError();
        grid = cus;
    }
    if (grid < 0) return;
    if (hipMemsetAsync((char*)d_ws + WS_CTL, 0, CTL_ZERO_BYTES, stream) != hipSuccess) return;
    Args a{};
    for (int i = 0; i < 18; ++i) a.in[i] = (const float*)d_in[i];
    a.out = (float*)d_out; a.ws = (unsigned char*)d_ws;
#if MK_PER_PHASE
    for (int p = 0; p < NPHASE; ++p) { a.ph_lo = p; a.ph_hi = p + 1; hipLaunchKernelGGL(hybrid_fwd, dim3(grid), dim3(NWAVES * 64), LDS_BYTES, stream, a); }
#else
    a.ph_lo = 0; a.ph_hi = NPHASE;
    hipLaunchKernelGGL(hybrid_fwd, dim3(grid), dim3(NWAVES * 64), LDS_BYTES, stream, a);
#endif
}
```

```cpp
#include <hip/hip_runtime.h>
#include <cstdio>
#include <cstdint>
namespace pg8 {
#define PG8_LAS __attribute__((address_space(3)))
typedef unsigned short bf16_t;
typedef short bf16x8 __attribute__((ext_vector_type(8)));
typedef float f32x4 __attribute__((ext_vector_type(4)));
typedef unsigned u32x4 __attribute__((ext_vector_type(4)));
constexpr int BM = 256, BK = 64, HALF = 128, HTB = HALF * BK * 2  , STAGE_BYTES = 8 * HTB, NXCD = 8, WGM = 8;

__host__ __device__ __forceinline__ int lds_byte(int r, int c) { const int st = (r >> 4) * 2 + (c >> 5), rr = r & 15, cc = c & 31, ob = rr * 64 + cc * 2; return st * 1024 + (ob ^ (((ob >> 9) & 1) << 5)); }
__host__ __device__ __forceinline__ void stage_rc(int b, int& R, int& C) { const int st = b / 1024, sb = b % 1024, swz = sb ^ (((sb >> 9) & 1) << 5); R = (st >> 1) * 16 + swz / 64; C = (st & 1) * 32 + (swz % 64) / 2; }
__host__ __device__ __forceinline__ int perm32(int rho) { const int n = rho >> 4, i = rho & 15; return 8 * (i >> 2) + 4 * n + (i & 3); }

struct Unit { int pm, pn, slot; };
struct Gemm { const bf16_t* A; const bf16_t* Bt; int M, N, K; };

struct StaticOrder {
    int nM, nN, nwg, G, c;
    __host__ __device__ void init(int M, int N, int G_, int c_) { nM = M / BM; nN = N / BM; nwg = nM * nN; G = G_; c = c_; }
    __host__ __device__ bool next(int i, Unit& u) const {
        const long L = (long)i * G + c; if (L >= nwg) return false;
        int wgid = (int)L; { const int q = nwg / NXCD, r = nwg % NXCD, xcd = wgid % NXCD, off = wgid / NXCD; wgid = (xcd < r ? xcd * (q + 1) : r * (q + 1) + (xcd - r) * q) + off; }
        const int nig = WGM * nN, gid = wgid / nig, fm = gid * WGM, gsz = (nM - fm) < WGM ? (nM - fm) : WGM;
        u.pm = fm + ((wgid % nig) % gsz); u.pn = (wgid % nig) / gsz; u.slot = i; return true;
    }
    __device__ __forceinline__ void a_ready(const Unit&) const {}
    __device__ __forceinline__ void done(const Unit&) const {}
};

__device__ __forceinline__ unsigned cvt_pk_bf16(float lo, float hi) { unsigned r; asm volatile("v_cvt_pk_bf16_f32 %0, %1, %2" : "=v"(r) : "v"(lo), "v"(hi)); return r; }
constexpr int SEQ = 16384, DM = 1024;
constexpr float RMS_EPS = 1e-6f;
__device__ __forceinline__ float row_rs(const float* ss, int row) {
    const f32x4* p = (const f32x4*)(ss + (size_t)row * 16); const f32x4 a = p[0], b = p[1], c = p[2], d = p[3];
    const float s = (((a[0] + a[1]) + (a[2] + a[3])) + ((b[0] + b[1]) + (b[2] + b[3]))) + (((c[0] + c[1]) + (c[2] + c[3])) + ((d[0] + d[1]) + (d[2] + d[3])));
    return 1.0f / sqrtf(s * (1.0f / 1024.0f) + RMS_EPS);
}
template <int MODE> struct EpiIn {
    static constexpr bool PERM = true, AFTER_DRAIN = false;
    bf16_t* O; const PG8_LAS float* rsl; const float* rope; int nsc; float scale0;
    float* ksum;
    __device__ __forceinline__ void operator()(const f32x4 (&acc)[2][2][4][2], const Unit& u, int wr, int wc, int fr, int fq) const {
        const int row0 = u.pm * BM + wr * 64 + fr;
        if (MODE == 2 && u.pn >= 4) {
            bf16_t* base = O + (size_t)SEQ * DM + (u.pn - 4) * 128 + wc * 32 + 8 * fq;
#pragma unroll
            for (int ai = 0; ai < 2; ++ai)
#pragma unroll
                for (int m = 0; m < 4; ++m) { const int row = row0 + ai * HALF + m * 16; const float rs = rsl[u.slot * 256 + (row & 255)], r2 = rs * rs;
                    const f32x4 v0 = acc[ai][0][m][0] * acc[ai][1][m][0] * r2, v1 = acc[ai][0][m][1] * acc[ai][1][m][1] * r2;
                    u32x4 w; w.x = cvt_pk_bf16(v0[0], v0[1]); w.y = cvt_pk_bf16(v0[2], v0[3]); w.z = cvt_pk_bf16(v1[0], v1[1]); w.w = cvt_pk_bf16(v1[2], v1[3]);
                    *(u32x4*)(base + (size_t)row * DM) = w; }
            return;
        }
        const int t = u.pn >> 2; bf16_t* base = O + (size_t)t * SEQ * DM + (u.pn & 3) * BM + wc * 32 + 8 * fq;
        const float sc = (u.pn < nsc) ? scale0 : 1.0f;
        const bool rot = (MODE == 1) && (t < 2) && ((wc & 1) == 0);
        f32x4 cs[2][2] = {{{0.f, 0.f, 0.f, 0.f}, {0.f, 0.f, 0.f, 0.f}}, {{0.f, 0.f, 0.f, 0.f}, {0.f, 0.f, 0.f, 0.f}}};
#pragma unroll
        for (int ai = 0; ai < 2; ++ai)
#pragma unroll
            for (int m = 0; m < 4; ++m) { const int row = row0 + ai * HALF + m * 16; const float rs = rsl[u.slot * 256 + (row & 255)] * sc;
                f32x4 c0 = {1.f, 1.f, 1.f, 1.f}, c1 = c0, s0 = {0.f, 0.f, 0.f, 0.f}, s1 = s0;
                if (MODE == 1) { if (rot) { const f32x4* rp = (const f32x4*)(rope + (size_t)row * 16); c0 = rp[0]; c1 = rp[1]; s0 = rp[2]; s1 = rp[3]; if (fq == 0) { s0 = -s0; s1 = -s1; } } }
#pragma unroll
                for (int bj = 0; bj < 2; ++bj) { f32x4 v0 = acc[ai][bj][m][0] * rs, v1 = acc[ai][bj][m][1] * rs;
                    if (MODE == 1) { if (rot) {
                        f32x4 p0, p1;
#pragma unroll
                        for (int e = 0; e < 4; ++e) { p0[e] = __shfl_xor(v0[e], 16); p1[e] = __shfl_xor(v1[e], 16); }
                        if (fq < 2) { v0 = v0 * c0 + p0 * s0; v1 = v1 * c1 + p1 * s1; } } }
                    if (MODE == 1) { cs[bj][0] += v0; cs[bj][1] += v1; }
                    u32x4 w; w.x = cvt_pk_bf16(v0[0], v0[1]); w.y = cvt_pk_bf16(v0[2], v0[3]); w.z = cvt_pk_bf16(v1[0], v1[1]); w.w = cvt_pk_bf16(v1[2], v1[3]);
                    *(u32x4*)(base + (size_t)row * DM + bj * HALF) = w; } }
        if (MODE == 1) { if (t == 1) {
#pragma unroll
            for (int bj = 0; bj < 2; ++bj)
#pragma unroll
                for (int n = 0; n < 2; ++n)
#pragma unroll
                    for (int e = 0; e < 4; ++e) { float x = cs[bj][n][e]; x += __shfl_xor(x, 1); x += __shfl_xor(x, 2); x += __shfl_xor(x, 4); x += __shfl_xor(x, 8);
                        if (fr == 0) { const int c = (u.pn & 3) * BM + bj * HALF + wc * 32 + 8 * fq + 4 * n + e; atomicAdd(ksum + ((size_t)(c >> 6) * 64 + u.pm) * 64 + (c & 63), x); } } } }
    }
};
template <bool RES_F32> struct EpiRes {
    static constexpr bool PERM = true, AFTER_DRAIN = false;
    const float* res; bf16_t* hb; float* ss;
    __device__ __forceinline__ void operator()(const f32x4 (&acc)[2][2][4][2], const Unit& u, int wr, int wc, int fr, int fq) const {
        const int row0 = u.pm * BM + wr * 64 + fr, col0 = u.pn * BM + wc * 32 + 8 * fq;
#pragma unroll
        for (int ai = 0; ai < 2; ++ai)
#pragma unroll
            for (int m = 0; m < 4; ++m) { const int row = row0 + ai * HALF + m * 16; const size_t off = (size_t)row * DM + col0; float q = 0.f;
#pragma unroll
                for (int bj = 0; bj < 2; ++bj) { f32x4 r0, r1;
                    if (RES_F32) { r0 = *(const f32x4*)(res + off + bj * HALF); r1 = *(const f32x4*)(res + off + bj * HALF + 4); }
                    else { const u32x4 rw = *(const u32x4*)(hb + off + bj * HALF);
                        r0 = (f32x4){__builtin_bit_cast(float, rw.x << 16), __builtin_bit_cast(float, rw.x & 0xffff0000u), __builtin_bit_cast(float, rw.y << 16), __builtin_bit_cast(float, rw.y & 0xffff0000u)};
                        r1 = (f32x4){__builtin_bit_cast(float, rw.z << 16), __builtin_bit_cast(float, rw.z & 0xffff0000u), __builtin_bit_cast(float, rw.w << 16), __builtin_bit_cast(float, rw.w & 0xffff0000u)}; }
                    const f32x4 h0 = r0 + acc[ai][bj][m][0], h1 = r1 + acc[ai][bj][m][1];
                    u32x4 w; w.x = cvt_pk_bf16(h0[0], h0[1]); w.y = cvt_pk_bf16(h0[2], h0[3]); w.z = cvt_pk_bf16(h1[0], h1[1]); w.w = cvt_pk_bf16(h1[2], h1[3]);
                    *(u32x4*)(hb + off + bj * HALF) = w;
                    q += ((h0[0] * h0[0] + h0[1] * h0[1]) + (h0[2] * h0[2] + h0[3] * h0[3])) + ((h1[0] * h1[0] + h1[1] * h1[1]) + (h1[2] * h1[2] + h1[3] * h1[3])); }
                q += __shfl_xor(q, 16); q += __shfl_xor(q, 32);
                if (fq == 0) ss[(size_t)row * 16 + u.pn * 4 + wc] = q; }
    }
};
struct EpiGlu {
    static constexpr bool PERM = true, AFTER_DRAIN = false;
    bf16_t* Hd; int ldh; const PG8_LAS float* rsl;
    __device__ __forceinline__ void operator()(const f32x4 (&acc)[2][2][4][2], const Unit& u, int wr, int wc, int fr, int fq) const {
        const int row0 = u.pm * BM + wr * 64 + fr; bf16_t* base = Hd + u.pn * 128 + wc * 32 + 8 * fq;
#pragma unroll
        for (int ai = 0; ai < 2; ++ai)
#pragma unroll
            for (int m = 0; m < 4; ++m) { const int row = row0 + ai * HALF + m * 16; const float rs = rsl[u.slot * 256 + (row & 255)]; float o[8];
#pragma unroll
                for (int n = 0; n < 2; ++n)
#pragma unroll
                    for (int e = 0; e < 4; ++e) { const float g = acc[ai][0][m][n][e] * rs, up = acc[ai][1][m][n][e] * rs;
                        o[n * 4 + e] = g * __builtin_amdgcn_rcpf(1.0f + __builtin_amdgcn_exp2f(g * -1.4426950408889634f)) * up; }
                u32x4 w; w.x = cvt_pk_bf16(o[0], o[1]); w.y = cvt_pk_bf16(o[2], o[3]); w.z = cvt_pk_bf16(o[4], o[5]); w.w = cvt_pk_bf16(o[6], o[7]);
                *(u32x4*)(base + (size_t)row * ldh) = w; }
    }
};

template <class Epi, class Sched, bool ALIGN_EPI = false, bool SP2 = false>
__device__ __forceinline__ void gemm_phase(PG8_LAS unsigned char* lds, const Gemm g, const Sched& S, const Epi& E) {
    const int tid = threadIdx.x, wid = __builtin_amdgcn_readfirstlane(tid >> 6), lane = tid & 63, wr = wid >> 2, wc = wid & 3, fr = lane & 15, fq = lane >> 4;
    const int K = g.K, nt = K / BK;
    unsigned voffA[2], voffB[2];
#pragma unroll
    for (int i = 0; i < 2; ++i) { int R, C; stage_rc(tid * 16 + i * 8192, R, C); const int Rb = Epi::PERM ? ((R & ~31) + perm32(R & 31)) : R;
        voffA[i] = (unsigned)(R * K + C) * 2u; voffB[i] = (unsigned)(Rb * K + C) * 2u; }
    const size_t kstep = (size_t)(BK * 2);
    const size_t hstep = (size_t)HALF * K * 2;
    const size_t tstep = 2 * hstep;
    const unsigned ldsw = (unsigned)wid * 1024u;
    const int aoff = lds_byte(wr * 64 + fr, fq * 8), boff = lds_byte(wc * 32 + fr, fq * 8);
#define PG8_SA(b, h) (((b) * 2 + (h)) * HTB)
#define PG8_SB(b, h) ((4 + (b) * 2 + (h)) * HTB)
#define PG8_STAGE(bufoff, gbase, voff) do { _Pragma("unroll") for (int _i = 0; _i < 2; ++_i) \
        __builtin_amdgcn_global_load_lds((const unsigned*)((const char*)(gbase) + (voff)[_i]), (PG8_LAS unsigned*)(lds + (bufoff) + ldsw + _i * 8192), 16, 0, 0); } while (0)
#define PG8_LDA(dst, b, h) do { _Pragma("unroll") for (int m = 0; m < 4; ++m) _Pragma("unroll") for (int k = 0; k < 2; ++k) dst[m][k] = *(const PG8_LAS bf16x8*)(lds + PG8_SA(b, h) + aoff + m * 2048 + k * 1024); } while (0)
#define PG8_LDB(dst, b, h) do { _Pragma("unroll") for (int n = 0; n < 2; ++n) _Pragma("unroll") for (int k = 0; k < 2; ++k) dst[n][k] = *(const PG8_LAS bf16x8*)(lds + PG8_SB(b, h) + boff + n * 2048 + k * 1024); } while (0)
#define PG8_MMA(ai, bj, At, Bt) do { __builtin_amdgcn_s_setprio(1); _Pragma("unroll") for (int m = 0; m < 4; ++m) _Pragma("unroll") for (int n = 0; n < 2; ++n) _Pragma("unroll") for (int k = 0; k < 2; ++k) \
        acc[ai][bj][m][n] = __builtin_amdgcn_mfma_f32_16x16x32_bf16(Bt[n][k], At[m][k], acc[ai][bj][m][n], 0, 0, 0); __builtin_amdgcn_s_setprio(0); } while (0)
#define PG8_WAIT_V(n) asm volatile("s_waitcnt vmcnt(" #n ")" ::: "memory")
#define PG8_WAIT_L(n) asm volatile("s_waitcnt lgkmcnt(" #n ")" ::: "memory")
#define PG8_BAR __builtin_amdgcn_s_barrier()
#define PG8_SCHED __builtin_amdgcn_sched_barrier(0)
    Unit cur, nxt; int ui = 0;
    if (!S.next(0, cur)) return;
    f32x4 acc[2][2][4][2];
#pragma unroll
    for (int a = 0; a < 2; ++a)
#pragma unroll
        for (int b = 0; b < 2; ++b)
#pragma unroll
            for (int m = 0; m < 4; ++m)
#pragma unroll
                for (int n = 0; n < 2; ++n) acc[a][b][m][n] = (f32x4){0.f, 0.f, 0.f, 0.f};
    bf16x8 At[4][2], B0[2][2], B1[2][2];
    const char* cA = (const char*)g.A + (size_t)cur.pm * tstep; const char* cB = (const char*)g.Bt + (size_t)cur.pn * tstep;
    S.a_ready(cur);
    if constexpr (SP2) {
        PG8_STAGE(PG8_SB(0, 0), cB, voffB); PG8_STAGE(PG8_SB(0, 1), cB + hstep, voffB); PG8_STAGE(PG8_SA(0, 0), cA, voffA); PG8_STAGE(PG8_SA(0, 1), cA + hstep, voffA);
        if (wr == 1) PG8_BAR;
        PG8_WAIT_V(2); PG8_BAR;
        PG8_STAGE(PG8_SB(1, 0), cB + kstep, voffB); PG8_STAGE(PG8_SA(1, 0), cA + kstep, voffA); PG8_STAGE(PG8_SB(1, 1), cB + hstep + kstep, voffB);
        PG8_WAIT_V(6); PG8_BAR;
    } else {
        PG8_STAGE(PG8_SB(0, 0), cB, voffB); PG8_STAGE(PG8_SA(0, 0), cA, voffA); PG8_STAGE(PG8_SB(0, 1), cB + hstep, voffB); PG8_STAGE(PG8_SA(0, 1), cA + hstep, voffA);
        if (wr == 1) PG8_BAR;
        PG8_WAIT_V(4); PG8_BAR;
        PG8_STAGE(PG8_SB(1, 0), cB + kstep, voffB); PG8_STAGE(PG8_SA(1, 0), cA + kstep, voffA); PG8_STAGE(PG8_SB(1, 1), cB + hstep + kstep, voffB);
        PG8_WAIT_V(6); PG8_BAR;
    }
    for (;;) {
        const bool has_next = S.next(ui + 1, nxt);
        const char* nA = has_next ? (const char*)g.A + (size_t)nxt.pm * tstep : cA; const char* nB = has_next ? (const char*)g.Bt + (size_t)nxt.pn * tstep : cB;
        for (int t = 0; t < nt; t += 2) {
            const bool last = (t == nt - 2);
            const char* a1 = cA + (size_t)(t + 1) * kstep;
            const char* a2 = last ? nA : cA + (size_t)(t + 2) * kstep; const char* b2 = last ? nB : cB + (size_t)(t + 2) * kstep;
            const char* a3 = a2 + kstep; const char* b3 = b2 + kstep;
            if (last && has_next) S.a_ready(nxt);
            if constexpr (SP2) {
            PG8_LDB(B0, 0, 0); PG8_LDB(B1, 0, 1); PG8_SCHED; PG8_LDA(At, 0, 0); PG8_STAGE(PG8_SA(1, 1), a1 + hstep, voffA);
            PG8_WAIT_V(8); PG8_WAIT_L(0); PG8_BAR; PG8_MMA(0, 0, At, B0); PG8_MMA(0, 1, At, B1); PG8_BAR; PG8_SCHED;
            PG8_LDA(At, 0, 1); PG8_STAGE(PG8_SB(0, 0), b2, voffB); PG8_STAGE(PG8_SB(0, 1), b2 + hstep, voffB); PG8_STAGE(PG8_SA(0, 0), a2, voffA);
            PG8_WAIT_V(8); PG8_WAIT_L(0); PG8_BAR; PG8_MMA(1, 0, At, B0); PG8_MMA(1, 1, At, B1); PG8_BAR; PG8_SCHED;
            PG8_LDB(B0, 1, 0); PG8_LDB(B1, 1, 1); PG8_SCHED; PG8_LDA(At, 1, 0); PG8_STAGE(PG8_SA(0, 1), a2 + hstep, voffA);
            PG8_WAIT_V(8); PG8_WAIT_L(0); PG8_BAR; PG8_MMA(0, 0, At, B0); PG8_MMA(0, 1, At, B1); PG8_BAR; PG8_SCHED;
            PG8_LDA(At, 1, 1); PG8_STAGE(PG8_SB(1, 0), b3, voffB); PG8_STAGE(PG8_SB(1, 1), b3 + hstep, voffB); PG8_STAGE(PG8_SA(1, 0), a3, voffA);
            PG8_WAIT_V(8); PG8_WAIT_L(0); PG8_BAR; PG8_MMA(1, 0, At, B0); PG8_MMA(1, 1, At, B1); PG8_BAR; PG8_SCHED;
            } else {
            PG8_LDB(B0, 0, 0); PG8_SCHED; PG8_LDA(At, 0, 0); PG8_STAGE(PG8_SA(1, 1), a1 + hstep, voffA);
            PG8_WAIT_L(8); PG8_BAR; PG8_WAIT_L(0); PG8_MMA(0, 0, At, B0); PG8_BAR; PG8_SCHED;
            PG8_LDB(B1, 0, 1); PG8_STAGE(PG8_SB(0, 0), b2, voffB);
            PG8_BAR; PG8_WAIT_L(0); PG8_MMA(0, 1, At, B1); PG8_BAR;
            PG8_LDA(At, 0, 1); PG8_STAGE(PG8_SA(0, 0), a2, voffA);
            PG8_BAR; PG8_WAIT_L(0); PG8_MMA(1, 0, At, B0); PG8_BAR; PG8_SCHED;
            PG8_STAGE(PG8_SB(0, 1), b2 + hstep, voffB);
            PG8_WAIT_V(6); PG8_BAR; PG8_MMA(1, 1, At, B1); PG8_BAR;
            PG8_LDB(B0, 1, 0); PG8_SCHED; PG8_LDA(At, 1, 0); PG8_STAGE(PG8_SA(0, 1), a2 + hstep, voffA);
            PG8_WAIT_L(8); PG8_BAR; PG8_WAIT_L(0); PG8_MMA(0, 0, At, B0); PG8_BAR; PG8_SCHED;
            PG8_LDB(B1, 1, 1); PG8_STAGE(PG8_SB(1, 0), b3, voffB);
            PG8_BAR; PG8_WAIT_L(0); PG8_MMA(0, 1, At, B1); PG8_BAR;
            PG8_LDA(At, 1, 1); PG8_STAGE(PG8_SA(1, 0), a3, voffA);
            PG8_BAR; PG8_WAIT_L(0); PG8_MMA(1, 0, At, B0); PG8_BAR; PG8_SCHED;
            PG8_STAGE(PG8_SB(1, 1), b3 + hstep, voffB);
            PG8_WAIT_V(6); PG8_BAR; PG8_MMA(1, 1, At, B1); PG8_BAR;
            }
        }
        if constexpr (ALIGN_EPI) { if (wr == 0) PG8_BAR; }
        if constexpr (!Epi::AFTER_DRAIN) { E(acc, cur, wr, wc, fr, fq); S.done(cur); }
        if (!has_next) break;
#pragma unroll
        for (int a = 0; a < 2; ++a)
#pragma unroll
            for (int b = 0; b < 2; ++b)
#pragma unroll
                for (int m = 0; m < 4; ++m)
#pragma unroll
                    for (int n = 0; n < 2; ++n) acc[a][b][m][n] = (f32x4){0.f, 0.f, 0.f, 0.f};
        cur = nxt; cA = nA; cB = nB; ++ui;
        if constexpr (ALIGN_EPI) { if (wr == 1) PG8_BAR; }
    }
    PG8_WAIT_V(0);
    if constexpr (!ALIGN_EPI) { if (wr == 0) PG8_BAR; }
    PG8_BAR;
    if constexpr (Epi::AFTER_DRAIN) { E.fused(acc, cur, wr, wc, fr, fq, lds, wid, lane); S.done(cur); }
#undef PG8_SA
#undef PG8_SB
#undef PG8_STAGE
#undef PG8_LDA
#undef PG8_LDB
#undef PG8_MMA
#undef PG8_WAIT_V
#undef PG8_WAIT_L
#undef PG8_BAR
#undef PG8_SCHED
}
}

constexpr int NWAVES = 8;
constexpr int S = 16384, D = 1024, FF = 2816, NHEAD = 16, DH = 64;
constexpr int ML_H = 4, ML_DK = 128, ML_DV = 256, ML_L = 128, ML_NC = S / ML_L, ML_IN = 3080;
constexpr int MB_BLK = 256, MB_NB = S / MB_BLK;
constexpr float EPS = 1e-6f;
constexpr float C2 = 0.125f * 1.4426950408889634f;
#ifndef MK_PER_PHASE
#define MK_PER_PHASE 0
#endif
constexpr int NPHASE = 26;
#ifndef PROBE_MASK
#define PROBE_MASK 0u
#endif
#define PROBE_MULT 4
#define PROBE_BLOCK 0
#define PROBE_PRE 0

constexpr size_t MiB = 1u << 20;
constexpr size_t WS_CTL = 0, CTL_ZERO_BYTES = 320 * 1024;
constexpr size_t WS_SS = 1 * MiB;
constexpr size_t WS_GATES = 2 * MiB;
constexpr size_t WS_ROPE = 3 * MiB;
constexpr size_t WS_GA = 4 * MiB;
constexpr size_t WS_MST = WS_GA + 8192;
constexpr size_t WS_ND = WS_GA + 16384;
constexpr size_t WS_NST = WS_ND + 262144;
constexpr size_t WS_KMEAN = 65536;
constexpr size_t WS_CNT = 32768;
constexpr size_t WS_WIN = 8 * MiB, WS_WOUT = 14 * MiB, WS_WGU = 16 * MiB, WS_WD = 27 * MiB;
constexpr size_t WS_T0 = 33 * MiB, WS_T1 = 65 * MiB, WS_T2 = 97 * MiB;
constexpr size_t WS_HB = 129 * MiB;
constexpr size_t WS_X = 161 * MiB;
constexpr size_t WS_CT = WS_X;
constexpr size_t WS_PO2 = WS_X, WS_LSE = WS_X + 32 * MiB, WS_LIST = WS_X + 36 * MiB;
constexpr size_t WS_WGU1 = WS_LIST + 17 * MiB, WS_WD1 = WS_WGU1 + 11 * MiB;
constexpr size_t WS_END = WS_WD1 + 6 * MiB;
static_assert(WS_END <= 256 * MiB, "workspace map");
constexpr int LIST_HEAD_CAP = 256 * 2016;
constexpr int CW_BAR = 1024;

constexpr int LDS_BYTES = 147456;
constexpr int MISC_OFF = LDS_BYTES - 256;
constexpr int CONV_SCR = 8704, AUX_OFF = 8 * CONV_SCR;
constexpr int RSL_OFF = 131072;
constexpr int SCAL_OFF = 139264;

#define GAS __attribute__((address_space(1)))
#define LAS __attribute__((address_space(3)))
typedef unsigned short bf16;
typedef unsigned v4u __attribute__((ext_vector_type(4)));
typedef unsigned v2u __attribute__((ext_vector_type(2)));
typedef float f32x4 __attribute__((ext_vector_type(4)));
typedef float f32x16 __attribute__((ext_vector_type(16)));
typedef short bf16x8 __attribute__((ext_vector_type(8)));
typedef short s16x4 __attribute__((ext_vector_type(4)));
typedef GAS unsigned gu32;
#define RLX_AGENT __ATOMIC_RELAXED, __HIP_MEMORY_SCOPE_AGENT
#define LDS_WAIT() asm volatile("s_waitcnt lgkmcnt(0)" ::: "memory")
#define VM_WAIT() asm volatile("s_waitcnt vmcnt(0)" ::: "memory")
__device__ __forceinline__ unsigned f2bf(float f) { unsigned u = __builtin_bit_cast(unsigned, f); return (u + 0x7fffu + ((u >> 16) & 1u)) >> 16; }
__device__ __forceinline__ unsigned pk2(float lo, float hi) { return pg8::cvt_pk_bf16(lo, hi); }
__device__ __forceinline__ float bf_lo(unsigned w) { return __builtin_bit_cast(float, w << 16); }
__device__ __forceinline__ float bf_hi(unsigned w) { return __builtin_bit_cast(float, w & 0xffff0000u); }
__device__ __forceinline__ float ex2(float x) { return __builtin_amdgcn_exp2f(x); }
__device__ __forceinline__ float lg2(float x) { return __builtin_amdgcn_logf(x); }
__device__ __forceinline__ int crow(int r, int hi) { return (r & 3) + 8 * (r >> 2) + 4 * hi; }
#define MFMA32(a, b, c) __builtin_amdgcn_mfma_f32_32x32x16_bf16((a), (b), (c), 0, 0, 0)
typedef short v4i16_t __attribute__((ext_vector_type(4)));
__device__ __forceinline__ s16x4 ldtr(LAS const unsigned char* p) { return __builtin_bit_cast(s16x4, __builtin_amdgcn_ds_read_tr16_b64_v4i16((LAS v4i16_t*)p)); }
__device__ __forceinline__ bf16x8 cat8(s16x4 a, s16x4 b) { return (bf16x8){a[0], a[1], a[2], a[3], b[0], b[1], b[2], b[3]}; }
__device__ __forceinline__ int tr_lane_off(int lane, int stride) { return ((lane & 15) >> 2) * stride + (((lane >> 4) & 1) * 16 + (lane & 3) * 4) * 2; }
__device__ __forceinline__ bf16x8 frag_tr_nat(LAS const unsigned char* tile, int stride, int k0, int n0, int lane, int troff) {
    LAS const unsigned char* p = tile + (k0 + 8 * (lane >> 5)) * stride + n0 * 2 + troff; return cat8(ldtr(p), ldtr(p + 4 * stride)); }
__device__ __forceinline__ bf16x8 frag_tr_acc(LAS const unsigned char* tile, int stride, int k0, int n0, int lane, int troff) {
    LAS const unsigned char* p = tile + (k0 + 4 * (lane >> 5)) * stride + n0 * 2 + troff; return cat8(ldtr(p), ldtr(p + 8 * stride)); }
__device__ __forceinline__ bf16x8 frag_row(LAS const unsigned char* tile, int stride, int r0, int c0, int lane) {
    return *(LAS const bf16x8*)(tile + (r0 + (lane & 31)) * stride + (c0 + 8 * (lane >> 5)) * 2); }
__device__ __forceinline__ bf16x8 pack_acc(const f32x16& p, int s) {
    v4u w; w.x = pk2(p[8 * s + 0], p[8 * s + 1]); w.y = pk2(p[8 * s + 2], p[8 * s + 3]); w.z = pk2(p[8 * s + 4], p[8 * s + 5]); w.w = pk2(p[8 * s + 6], p[8 * s + 7]); return __builtin_bit_cast(bf16x8, w); }
__device__ __forceinline__ void halves(float x, float& half0, float& half1) { const unsigned u = __builtin_bit_cast(unsigned, x); auto rr = __builtin_amdgcn_permlane32_swap(u, u, false, false);
    half0 = __builtin_bit_cast(float, (unsigned)rr[0]); half1 = __builtin_bit_cast(float, (unsigned)rr[1]); }
__device__ __forceinline__ float hsum(float x) { float a, b; halves(x, a, b); return a + b; }
__device__ __forceinline__ float hmax(float x) { float a, b; halves(x, a, b); return fmaxf(a, b); }
__device__ __forceinline__ float max16(const f32x16& p) {
    const float a = fmaxf(fmaxf(p[0], p[1]), fmaxf(p[2], p[3])), b = fmaxf(fmaxf(p[4], p[5]), fmaxf(p[6], p[7])), c = fmaxf(fmaxf(p[8], p[9]), fmaxf(p[10], p[11])), d = fmaxf(fmaxf(p[12], p[13]), fmaxf(p[14], p[15]));
    return fmaxf(fmaxf(a, b), fmaxf(c, d)); }
__device__ __forceinline__ float sum16(const f32x16& p) { return (((p[0] + p[1]) + (p[2] + p[3])) + ((p[4] + p[5]) + (p[6] + p[7]))) + (((p[8] + p[9]) + (p[10] + p[11])) + ((p[12] + p[13]) + (p[14] + p[15]))); }
__device__ __forceinline__ float wave_sum(float v) {
#pragma unroll
    for (int o = 1; o < 64; o <<= 1) v += __shfl_xor(v, o);
    return v;
}
__device__ __forceinline__ float wave_max(float v) {
#pragma unroll
    for (int o = 1; o < 64; o <<= 1) v = fmaxf(v, __shfl_xor(v, o));
    return v;
}
#define XB_TMO      128
#define XB_XCNT(j)  (256  + 64 * (j))
#define XB_XSUB(j)  (1280 + 64 * (j))
#define XB_XGEN(j)  (2304 + 64 * (j))
#define XB_TOP      3328
#define XB_TOPGEN   3392
#define XCD_BAR_WORDS 3456
#define XB_SPIN_CAP (1u << 18)

__device__ __forceinline__ unsigned xb_ld(unsigned* p)              { return __hip_atomic_load(p, __ATOMIC_RELAXED, __HIP_MEMORY_SCOPE_AGENT); }
__device__ __forceinline__ unsigned xb_add(unsigned* p, unsigned v) { return __hip_atomic_fetch_add(p, v, __ATOMIC_RELAXED, __HIP_MEMORY_SCOPE_AGENT); }
__device__ __forceinline__ unsigned xb_xcc_id() { return (unsigned)__builtin_amdgcn_s_getreg((3 << 11) | 20) & 0xFu; }
#define XB_SPIN(cond, bar) do { unsigned _sp = 0; while (cond) { __builtin_amdgcn_s_sleep(1); \
    if ((++_sp & 255u) == 0u) { if (xb_ld(&(bar)[XB_TMO])) break; if (_sp > XB_SPIN_CAP) { atomicAdd(&(bar)[XB_TMO], 1u); break; } } } } while (0)

struct XcdBarrier {
    unsigned* bar; unsigned x;
    volatile LAS unsigned* st;
};

__device__ __forceinline__ XcdBarrier xcd_barrier_post(unsigned* bar, volatile LAS unsigned* st) {
    XcdBarrier b; b.bar = bar; b.x = xb_xcc_id(); b.st = st;
    if (threadIdx.x == 0) (void)xb_add(&bar[XB_XCNT(b.x)], 1u);
    return b;
}
__device__ __forceinline__ void xcd_barrier_complete(unsigned* bar, unsigned x, unsigned& nloc, unsigned& nx) {
    const unsigned G = gridDim.x * gridDim.y * gridDim.z;
    unsigned sum, cnt, mine, sp = 0u;
    for (;;) {
        sum = 0u; cnt = 0u; mine = 0u;
#pragma unroll
        for (unsigned j = 0; j < 16; ++j) { const unsigned c = xb_ld(&bar[XB_XCNT(j)]); sum += c; cnt += (c > 0u) ? 1u : 0u; mine = (j == x) ? c : mine; }
        if (sum == G) break;
        __builtin_amdgcn_s_sleep(1);
        if ((++sp & 255u) == 0u) { if (xb_ld(&bar[XB_TMO])) break; if (sp > XB_SPIN_CAP) { atomicAdd(&bar[XB_TMO], 1u); break; } }
    }
    nloc = mine > 0u ? mine : 1u; nx = cnt > 0u ? cnt : 1u;
}

__device__ __forceinline__ void xcd_barrier(const XcdBarrier& b) {
    asm volatile("s_waitcnt vmcnt(0)" ::: "memory");
    __syncthreads();
    if (threadIdx.x == 0) {
        unsigned* bar = b.bar;
        __builtin_amdgcn_s_waitcnt(0);
        unsigned nloc = b.st[0], nx = b.st[1];
        if (nloc == 0u) { xcd_barrier_complete(bar, b.x, nloc, nx); b.st[0] = nloc; b.st[1] = nx; }
        const unsigned old = xb_add(&bar[XB_XSUB(b.x)], 1u);
        const unsigned gen = old / nloc;
        if (old + 1u == (gen + 1u) * nloc) {
            __builtin_amdgcn_fence(__ATOMIC_RELEASE, "agent");
            asm volatile("s_waitcnt vmcnt(0)" ::: "memory");
            const unsigned og = xb_add(&bar[XB_TOP], 1u);
            const unsigned tg = og / nx;
            if (og + 1u == (tg + 1u) * nx) xb_add(&bar[XB_TOPGEN], 1u);
            else XB_SPIN(xb_ld(&bar[XB_TOPGEN]) == tg, bar);
            __builtin_amdgcn_fence(__ATOMIC_ACQUIRE, "agent");
            xb_add(&bar[XB_XGEN(b.x)], 1u);
            asm volatile("s_waitcnt vmcnt(0)" ::: "memory");
        } else {
            XB_SPIN(xb_ld(&bar[XB_XGEN(b.x)]) == gen, bar);
            __builtin_amdgcn_fence(__ATOMIC_ACQUIRE, "agent");
            asm volatile("s_waitcnt vmcnt(0)" ::: "memory");
        }
    }
    __syncthreads();
}

struct Frame {
    LAS unsigned char* lds;
    volatile LAS unsigned* MISC;
    gu32* ctl;
    int tid, lane, wave;
    int G;
    unsigned char* ws;
    const float* in[18]; float* out;
};
#define WSP(T, off) ((T*)(F.ws + (off)))

struct CvM { const float* W; const float* gain; bf16* WT; int ldw, K, nblk, nitems, kind, half, base; };
__device__ __forceinline__ CvM cvm(const float* W, int ldw, int K, int N, const float* gain, bf16* WT, int kind, int half, int base) { CvM m; m.W = W; m.gain = gain; m.WT = WT; m.ldw = ldw; m.K = K; m.nblk = N / 32; m.nitems = (K / 64) * (N / 32); m.kind = kind; m.half = half; m.base = base; return m; }
template <int NM> __device__ __forceinline__ CvM cv_pick(const CvM (&ms)[NM], int it, int& li) {
    CvM m = ms[0]; li = it; int acc = 0;
#pragma unroll
    for (int i = 1; i < NM; ++i) { acc += ms[i - 1].nitems; const bool t = it >= acc;
        m.W = t ? ms[i].W : m.W; m.gain = t ? ms[i].gain : m.gain; m.WT = t ? ms[i].WT : m.WT; m.ldw = t ? ms[i].ldw : m.ldw; m.K = t ? ms[i].K : m.K; m.nblk = t ? ms[i].nblk : m.nblk;
        m.nitems = t ? ms[i].nitems : m.nitems; m.kind = t ? ms[i].kind : m.kind; m.half = t ? ms[i].half : m.half; m.base = t ? ms[i].base : m.base; li = t ? it - acc : li; }
    return m;
}
__device__ __forceinline__ void cv_load(const CvM& m, int li, int lane, float (&v)[32]) {
    const int kb = li / m.nblk, nb = li - kb * m.nblk; const float* p = m.W + (size_t)(64 * kb + (lane >> 5)) * m.ldw + 32 * nb + (lane & 31);
#pragma unroll
    for (int i = 0; i < 32; ++i) v[i] = p[(size_t)(2 * i) * m.ldw];
}
__device__ __forceinline__ void cv_finish(const CvM& m, int li, int lane, const float (&v)[32], LAS float* scr) {
    const int kb = li / m.nblk, nb = li - kb * m.nblk, k0 = 64 * kb, n0 = 32 * nb;
    const int orow0 = (m.kind == 0) ? m.base + n0 : m.base + (n0 >> 7) * 256 + m.half * 128 + (n0 & 127);
#pragma unroll
    for (int i = 0; i < 32; ++i) scr[(2 * i + (lane >> 5)) * 33 + (lane & 31)] = v[i];
    const int c = lane & 7;
    f32x4 g0 = {1.f, 1.f, 1.f, 1.f}, g1 = g0; if (m.gain) { g0 = *(const f32x4*)(m.gain + k0 + 8 * c); g1 = *(const f32x4*)(m.gain + k0 + 8 * c + 4); }
    LDS_WAIT(); asm volatile("" ::: "memory");
#pragma unroll
    for (int j = 0; j < 4; ++j) { const int n = (lane >> 3) + 8 * j; const LAS float* s = scr + (8 * c) * 33 + n;
        v4u o; o.x = pk2(s[0 * 33] * g0[0], s[1 * 33] * g0[1]); o.y = pk2(s[2 * 33] * g0[2], s[3 * 33] * g0[3]); o.z = pk2(s[4 * 33] * g1[0], s[5 * 33] * g1[1]); o.w = pk2(s[6 * 33] * g1[2], s[7 * 33] * g1[3]);
        *(GAS v4u*)(m.WT + (size_t)(orow0 + n) * m.K + k0 + 8 * c) = o; }
    LDS_WAIT(); asm volatile("" ::: "memory");
}
template <int NM> __device__ __forceinline__ void convert_stream(Frame& F, const CvM (&ms)[NM], int b0) {
    LAS float* scr = (LAS float*)(F.lds + F.wave * CONV_SCR); const int gw = ((int)blockIdx.x - b0) * NWAVES + F.wave, NGW = (F.G - b0) * NWAVES, lane = F.lane;
    if ((int)blockIdx.x < b0) return;
    int total = 0;
#pragma unroll
    for (int i = 0; i < NM; ++i) total += ms[i].nitems;
    int it = gw; if (it >= total) return;
    float va[32], vb[32]; int li; CvM m = cv_pick(ms, it, li); cv_load(m, li, lane, va);
    for (;;) {
        const int itn = it + NGW; int lin = 0; CvM mn = m; const bool more = itn < total; if (more) { mn = cv_pick(ms, itn, lin); cv_load(mn, lin, lane, vb); }
        cv_finish(m, li, lane, va, scr); if (!more) break;
        const int itn2 = itn + NGW; int lin2 = 0; CvM mn2 = mn; const bool more2 = itn2 < total; if (more2) { mn2 = cv_pick(ms, itn2, lin2); cv_load(mn2, lin2, lane, va); }
        cv_finish(mn, lin, lane, vb, scr); if (!more2) break;
        it = itn2; m = mn2; li = lin2;
    }
}
__device__ __forceinline__ void convert_layer(Frame& F, int layer, int b0) {
    const float* g0 = F.in[2] + (size_t)layer * 2 * D; const float* g1 = g0 + D; bf16* WIN = WSP(bf16, WS_WIN);
    const float* wo = (layer == 0) ? F.in[6] : (layer == 1) ? F.in[8] : (layer == 2) ? F.in[11] : F.in[13];
    bf16* WGUb = (layer & 1) ? WSP(bf16, WS_WGU1) : WSP(bf16, WS_WGU); bf16* WDb = (layer & 1) ? WSP(bf16, WS_WD1) : WSP(bf16, WS_WD);
    const CvM m_out = cvm(wo, D, D, D, nullptr, WSP(bf16, WS_WOUT), 0, 0, 0), m_g = cvm(F.in[14] + (size_t)layer * D * FF, FF, D, FF, g1, WGUb, 1, 0, 0),
              m_u = cvm(F.in[15] + (size_t)layer * D * FF, FF, D, FF, g1, WGUb, 1, 1, 0), m_d = cvm(F.in[16] + (size_t)layer * FF * D, D, FF, D, nullptr, WDb, 0, 0, 0);
    if (layer == 2) { const CvM ms[7] = {cvm(F.in[9], 3 * D, D, D, g0, WIN, 0, 0, 0), cvm(F.in[9] + D, 3 * D, D, D, g0, WIN, 1, 0, D), cvm(F.in[9] + 2 * D, 3 * D, D, D, g0, WIN, 1, 1, D), m_out, m_g, m_u, m_d};
        convert_stream(F, ms, b0); }
    else { const CvM ms[5] = {cvm(layer == 0 ? F.in[3] : layer == 1 ? F.in[7] : F.in[12], layer == 0 ? ML_IN : 3 * D, D, 3 * D, g0, WIN, 0, 0, 0), m_out, m_g, m_u, m_d}; convert_stream(F, ms, b0); }
}

__device__ __forceinline__ void prologue_rows(Frame& F) {
    const float* x = F.in[0]; const float* g0 = F.in[2]; const float* win = F.in[3]; const float* bg = F.in[4];
    bf16* hb = WSP(bf16, WS_HB); float* ss = WSP(float, WS_SS); float* gates = WSP(float, WS_GATES);
    const int gw = blockIdx.x * NWAVES + F.wave, NGW = F.G * NWAVES, lane = F.lane;
    float gwt[4][4][8];
#pragma unroll
    for (int j = 0; j < 4; ++j) { const int d0 = 4 * (lane + 64 * j); const f32x4 gg = *(const f32x4*)(g0 + d0);
#pragma unroll
        for (int e = 0; e < 4; ++e) { const f32x4* wp = (const f32x4*)(win + (size_t)(d0 + e) * ML_IN + 3072); const f32x4 w0 = wp[0], w1 = wp[1];
#pragma unroll
            for (int k = 0; k < 4; ++k) { gwt[j][e][k] = w0[k] * gg[e]; gwt[j][e][4 + k] = w1[k] * gg[e]; } } }
    for (int row0 = gw; row0 < S; row0 += 2 * NGW) {
        const bool two = (row0 + NGW) < S; f32x4 vv[2][4];
#pragma unroll
        for (int rr = 0; rr < 2; ++rr) { const f32x4* xr = (const f32x4*)(x + (size_t)(rr && two ? row0 + NGW : row0) * D) + lane;
#pragma unroll
            for (int j = 0; j < 4; ++j) vv[rr][j] = xr[64 * j]; }
#pragma unroll
        for (int rr = 0; rr < 2; ++rr) { if (rr && !two) break; const int row = row0 + rr * NGW; float s = 0.f;
#pragma unroll
            for (int j = 0; j < 4; ++j) { const f32x4 v = vv[rr][j]; s += (v[0] * v[0] + v[1] * v[1]) + (v[2] * v[2] + v[3] * v[3]); }
            s = wave_sum(s);
            if (lane < 16) ss[(size_t)row * 16 + lane] = (lane == 0) ? s : 0.f;
            unsigned long long* o8 = (unsigned long long*)(hb + (size_t)row * D) + lane;
#pragma unroll
            for (int j = 0; j < 4; ++j) o8[64 * j] = (unsigned long long)pk2(vv[rr][j][0], vv[rr][j][1]) | ((unsigned long long)pk2(vv[rr][j][2], vv[rr][j][3]) << 32);
            float a[8];
#pragma unroll
            for (int k = 0; k < 8; ++k) a[k] = 0.f;
#pragma unroll
            for (int j = 0; j < 4; ++j)
#pragma unroll
                for (int e = 0; e < 4; ++e)
#pragma unroll
                    for (int k = 0; k < 8; ++k) a[k] += vv[rr][j][e] * gwt[j][e][k];
            float b4[4], b2[2], b1;
#pragma unroll
            for (int k = 0; k < 4; ++k) { const float keep = (lane & 4) ? a[k + 4] : a[k], give = (lane & 4) ? a[k] : a[k + 4]; b4[k] = keep + __shfl_xor(give, 4); }
#pragma unroll
            for (int k = 0; k < 2; ++k) { const float keep = (lane & 2) ? b4[k + 2] : b4[k], give = (lane & 2) ? b4[k] : b4[k + 2]; b2[k] = keep + __shfl_xor(give, 2); }
            { const float keep = (lane & 1) ? b2[1] : b2[0], give = (lane & 1) ? b2[0] : b2[1]; b1 = keep + __shfl_xor(give, 1); }
            b1 += __shfl_xor(b1, 8); b1 += __shfl_xor(b1, 16); b1 += __shfl_xor(b1, 32);
            const float r = 1.0f / sqrtf(s * (1.0f / D) + EPS);
            if (lane < 8) gates[(size_t)row * 8 + lane] = b1 * r + bg[lane]; }
    }
    const int* pos = (const int*)F.in[1]; float* rope = WSP(float, WS_ROPE);
    const double inv_rev[8] = {0.15915494309189535, 0.03086376340470123, 0.005985185712713705, 0.001160663641240061, 0.00022507907903927653, 4.364795279280289e-05, 8.464330808241401e-06, 1.6414262627950345e-06};
    for (int idx = blockIdx.x * 512 + F.tid; idx < S * 8; idx += F.G * 512) { const int t = idx >> 3, i = idx & 7;
        double ir = inv_rev[0];
#pragma unroll
        for (int k = 1; k < 8; ++k) ir = (i == k) ? inv_rev[k] : ir;
        const double rev = (double)pos[t] * ir; const float fr = (float)(rev - __builtin_rint(rev));
        rope[(size_t)t * 16 + i] = __builtin_amdgcn_cosf(fr); rope[(size_t)t * 16 + 8 + i] = __builtin_amdgcn_sinf(fr); }
}

__device__ __forceinline__ void ml_chunk_scalars(const float* gates, int c, int hh, int lane, float& b0, float& b1, float& cs0, float& cs1, float& G, float& csmax) {
    const int t0 = c * ML_L + 2 * lane;
    const float f0 = gates[(size_t)t0 * 8 + 4 + hh], f1 = gates[(size_t)(t0 + 1) * 8 + 4 + hh], i0 = gates[(size_t)t0 * 8 + hh], i1 = gates[(size_t)(t0 + 1) * 8 + hh];
    const float l0 = fminf(f0, 0.f) - __logf(1.0f + __expf(-fabsf(f0))), l1 = fminf(f1, 0.f) - __logf(1.0f + __expf(-fabsf(f1)));
    float inc = l0 + l1;
#pragma unroll
    for (int o = 1; o < 64; o <<= 1) { const float t = __shfl_up(inc, o); if (lane >= o) inc += t; }
    b1 = inc; b0 = inc - l1; cs0 = i0 - b0; cs1 = i1 - b1;
    G = __shfl(inc, 63); csmax = wave_max(fmaxf(cs0, cs1));
}
template <int COLS> __device__ __forceinline__ void ml_load_tile(const bf16* g, int gp, LAS unsigned char* tile, int ls, int tid) {
    const int row = tid >> 2, seg = tid & 3; constexpr int PER = COLS / 4;
    const v4u* src = (const v4u*)(g + (size_t)row * gp + seg * PER); LAS v4u* dst = (LAS v4u*)(tile + row * ls + seg * PER * 2);
#pragma unroll
    for (int i = 0; i < PER / 8; ++i) dst[i] = src[i];
}
constexpr int ML_TS = 272;
__device__ __forceinline__ void mlstm_phase_a(Frame& F) {
    const bf16* T0 = WSP(bf16, WS_T0); const bf16* T1 = WSP(bf16, WS_T1); const float* gates = WSP(float, WS_GATES);
    float* Dt = F.out; float* nD = WSP(float, WS_ND); float* GA = WSP(float, WS_GA);
    LAS unsigned char* kw = F.lds; LAS unsigned char* vt = F.lds + 34816; constexpr int VS = 528;
    LAS float* wsc = (LAS float*)(F.lds + SCAL_OFF);
    const int tid = F.tid, lane = F.lane, w = F.wave, hi = lane >> 5, qn = lane & 31;
    for (int u = blockIdx.x; u < ML_NC * ML_H; u += F.G) { const int c = u >> 2, hh = u & 3;
        if (w == 0) { float b0, b1, cs0, cs1, G, cm; ml_chunk_scalars(gates, c, hh, lane, b0, b1, cs0, cs1, G, cm);
            wsc[2 * lane] = __expf(cs0 - cm); wsc[2 * lane + 1] = __expf(cs1 - cm);
            if (lane == 0) { GA[(size_t)u * 2] = G; GA[(size_t)u * 2 + 1] = G + cm; } }
        __syncthreads();
        {
            const int row = tid >> 2, seg = tid & 3; const float ws_ = wsc[row];
            const v4u* src = (const v4u*)(T0 + (size_t)(c * ML_L + row) * D + 512 + hh * ML_DK + seg * 32); LAS v4u* dst = (LAS v4u*)(kw + row * ML_TS + seg * 64);
#pragma unroll
            for (int i = 0; i < 4; ++i) { const v4u x = src[i]; v4u y;
                y.x = pk2(bf_lo(x.x) * ws_, bf_hi(x.x) * ws_); y.y = pk2(bf_lo(x.y) * ws_, bf_hi(x.y) * ws_); y.z = pk2(bf_lo(x.z) * ws_, bf_hi(x.z) * ws_); y.w = pk2(bf_lo(x.w) * ws_, bf_hi(x.w) * ws_); dst[i] = y; }
            ml_load_tile<256>(T1 + (size_t)(c * ML_L) * D + hh * ML_DV, D, vt, VS, tid);
        }
        __syncthreads();
        { const int tk = tr_lane_off(lane, ML_TS), tv = tr_lane_off(lane, VS);
          f32x16 acc[4];
#pragma unroll
          for (int i = 0; i < 4; ++i) acc[i] = (f32x16){};
#pragma unroll
          for (int ks = 0; ks < 8; ++ks) { const bf16x8 a = frag_tr_nat(vt, VS, 16 * ks, 32 * w, lane, tv);
#pragma unroll
              for (int dkt = 0; dkt < 4; ++dkt) { const bf16x8 b = frag_tr_nat(kw, ML_TS, 16 * ks, 32 * dkt, lane, tk); acc[dkt] = MFMA32(a, b, acc[dkt]); } }
          float* dst = Dt + (size_t)u * ML_DV * ML_DK;
#pragma unroll
          for (int dkt = 0; dkt < 4; ++dkt)
#pragma unroll
              for (int r = 0; r < 16; ++r) dst[(size_t)(32 * w + crow(r, hi)) * ML_DK + 32 * dkt + qn] = acc[dkt][r];
        }
        { float s = 0.f; const LAS bf16* col = (const LAS bf16*)kw + (tid & 127) + (tid >> 7) * 32 * (ML_TS / 2);
#pragma unroll 8
            for (int r = 0; r < 32; ++r) s += __builtin_bit_cast(float, (unsigned)col[r * (ML_TS / 2)] << 16);
            wsc[256 + tid] = s; }
        __syncthreads();
        if (tid < ML_DK) nD[(size_t)u * ML_DK + tid] = (wsc[256 + tid] + wsc[384 + tid]) + (wsc[512 + tid] + wsc[640 + tid]);
        __syncthreads();
    }
}
__device__ __forceinline__ void mlstm_phase_scan(Frame& F) {
    const float* GA = WSP(float, WS_GA); const float* Dt = F.out; const float* nD = WSP(float, WS_ND);
    bf16* Ct = WSP(bf16, WS_CT); float* nst = WSP(float, WS_NST); float* mst = WSP(float, WS_MST);
    LAS float* dec = (LAS float*)F.lds; LAS float* inj = dec + 512;
    if (F.wave < ML_H) { const int hh = F.wave, lane = F.lane;
        const float G0 = GA[(size_t)((2 * lane) * 4 + hh) * 2], A0 = GA[(size_t)((2 * lane) * 4 + hh) * 2 + 1], G1 = GA[(size_t)((2 * lane + 1) * 4 + hh) * 2], A1 = GA[(size_t)((2 * lane + 1) * 4 + hh) * 2 + 1];
        float inc = G0 + G1;
#pragma unroll
        for (int o = 1; o < 64; o <<= 1) { const float t = __shfl_up(inc, o); if (lane >= o) inc += t; }
        const float PG0 = inc - (G0 + G1), PG1 = PG0 + G0, x0 = A0 - PG1, x1 = A1 - inc;
        float pm = fmaxf(x0, x1);
#pragma unroll
        for (int o = 1; o < 64; o <<= 1) { const float t = __shfl_up(pm, o); if (lane >= o) pm = fmaxf(pm, t); }
        float pmx = __shfl_up(pm, 1); if (lane == 0) pmx = -3.0e38f;
        const float mx0 = fmaxf(0.f, pmx), mx1 = fmaxf(mx0, x0), mx2 = fmaxf(mx1, x1);
        const float m0 = PG0 + mx0, m1 = PG1 + mx1, m2 = inc + mx2;
        dec[hh * 128 + 2 * lane] = __expf(G0 + m0 - m1); inj[hh * 128 + 2 * lane] = __expf(A0 - m1);
        dec[hh * 128 + 2 * lane + 1] = __expf(G1 + m1 - m2); inj[hh * 128 + 2 * lane + 1] = __expf(A1 - m2);
        if (blockIdx.x == 0) { mst[(2 * lane) * 4 + hh] = m0; mst[(2 * lane + 1) * 4 + hh] = m1; } }
    __syncthreads();
    constexpr int NE = ML_H * ML_DV * ML_DK;
    for (int e = blockIdx.x * 512 + F.tid; e < NE; e += F.G * 512) { const int hh = e >> 15, rem = e & 32767; float C = 0.f;
        for (int c0 = 0; c0 < ML_NC; c0 += 16) { float dv[16];
#pragma unroll
            for (int i = 0; i < 16; ++i) dv[i] = Dt[(size_t)((c0 + i) * 4 + hh) * 32768 + rem];
#pragma unroll
            for (int i = 0; i < 16; ++i) { const size_t idx = (size_t)((c0 + i) * 4 + hh) * 32768 + rem; Ct[idx] = (bf16)f2bf(C); C = dec[hh * 128 + c0 + i] * C + inj[hh * 128 + c0 + i] * dv[i]; } } }
    for (int e = blockIdx.x * 512 + F.tid; e < ML_H * ML_DK; e += F.G * 512) { const int hh = e >> 7, dk = e & 127; float n = 0.f;
        for (int c0 = 0; c0 < ML_NC; c0 += 16) { float dv[16];
#pragma unroll
            for (int i = 0; i < 16; ++i) dv[i] = nD[(size_t)((c0 + i) * 4 + hh) * 128 + dk];
#pragma unroll
            for (int i = 0; i < 16; ++i) { nst[(size_t)((c0 + i) * 4 + hh) * 128 + dk] = n; n = dec[hh * 128 + c0 + i] * n + inj[hh * 128 + c0 + i] * dv[i]; } } }
    __syncthreads();
}
__device__ __forceinline__ void mlstm_phase_c(Frame& F) {
    const bf16* T0 = WSP(bf16, WS_T0); const bf16* T1 = WSP(bf16, WS_T1); bf16* T2 = WSP(bf16, WS_T2); const float* gates = WSP(float, WS_GATES);
    const bf16* Ct = WSP(bf16, WS_CT); const float* nst = WSP(float, WS_NST); const float* mst = WSP(float, WS_MST); const float* hgain = F.in[5];
    LAS unsigned char* qt = F.lds; LAS unsigned char* kt = F.lds + 34816; LAS unsigned char* vt = F.lds + 2 * 34816; LAS unsigned char* ct = F.lds + 3 * 34816;
    LAS float* sc = (LAS float*)(F.lds + SCAL_OFF);
    LAS float* sM = sc, * sCS = sc + 128, * sWI = sc + 256, * sEM = sc + 384, * sNV = sc + 512, * sQN = sc + 640, * sDS = sc + 768  , * sSQ = sc + 1024  , * sQP = sc + 1280  ;
    const int tid = F.tid, lane = F.lane, w = F.wave, hi = lane >> 5, qn = lane & 31, tb = w & 3, wh = w >> 2;
    const int trv = tr_lane_off(lane, ML_TS);
    for (int u = blockIdx.x; u < ML_NC * ML_H; u += F.G) { const int c = u >> 2, hh = u & 3; const int tok0 = c * ML_L;
        if (w == 0) { float b0, b1, cs0, cs1, G, cm; ml_chunk_scalars(gates, c, hh, lane, b0, b1, cs0, cs1, G, cm);
            const float mc = mst[u]; float inc = fmaxf(cs0, cs1);
#pragma unroll
            for (int o = 1; o < 64; o <<= 1) { const float t = __shfl_up(inc, o); if (lane >= o) inc = fmaxf(inc, t); }
            float ex = __shfl_up(inc, 1); if (lane == 0) ex = -3.0e38f;
            const float M0 = fmaxf(mc, fmaxf(ex, cs0)), M1 = fmaxf(mc, inc);
            sM[2 * lane] = M0; sM[2 * lane + 1] = M1; sCS[2 * lane] = cs0; sCS[2 * lane + 1] = cs1;
            sWI[2 * lane] = __expf(mc - M0); sWI[2 * lane + 1] = __expf(mc - M1); sEM[2 * lane] = __expf(-(b0 + M0)); sEM[2 * lane + 1] = __expf(-(b1 + M1)); }
        if (tid >= 64 && tid < 64 + ML_DK) sNV[tid - 64] = nst[(size_t)u * ML_DK + (tid - 64)];
        ml_load_tile<128>(T0 + (size_t)tok0 * D + hh * ML_DK, D, qt, ML_TS, tid);
        ml_load_tile<128>(T0 + (size_t)tok0 * D + 512 + hh * ML_DK, D, kt, ML_TS, tid);
        __syncthreads();
        int qn_l = qn; asm volatile("" : "+v"(qn_l));
        const int t = 32 * tb + qn; const float Mt = sM[t]; float rowsum = 0.f; v2u pp[2][4];
#pragma unroll
        for (int i = 0; i < 2; ++i) { const int st = 2 * wh + i;
#pragma unroll
            for (int g = 0; g < 4; ++g) pp[i][g] = (v2u){0u, 0u};
            if (st <= tb) { f32x16 a = {};
#pragma unroll
                for (int ks = 0; ks < 8; ++ks) a = MFMA32(frag_row(kt, ML_TS, 32 * st, 16 * ks, lane), frag_row(qt, ML_TS, 32 * tb, 16 * ks, lane), a);
#pragma unroll
                for (int r = 0; r < 16; ++r) a[r] *= __expf(sCS[32 * st + crow(r, hi)] - Mt);
                if (st == tb) {
#pragma unroll
                    for (int r = 0; r < 16; ++r) if (crow(r, hi) > qn_l) a[r] = 0.f; }
                rowsum += sum16(a);
#pragma unroll
                for (int g = 0; g < 4; ++g) pp[i][g] = (v2u){pk2(a[4 * g], a[4 * g + 1]), pk2(a[4 * g + 2], a[4 * g + 3])}; } }
        rowsum = hsum(rowsum);
        if (hi == 0) sDS[wh * 128 + t] = rowsum;
        __syncthreads();
        { LAS unsigned char* P = kt;
#pragma unroll
          for (int i = 0; i < 2; ++i)
#pragma unroll
              for (int g = 0; g < 4; ++g) *(LAS v2u*)(P + t * ML_TS + (32 * (2 * wh + i) + 8 * g + 4 * hi) * 2) = pp[i][g]; }
        { float s = 0.f; const int tq = tid & 127, dq = (tid >> 7) * 32; const LAS bf16* qr = (const LAS bf16*)(qt + tq * ML_TS) + dq;
#pragma unroll 8
            for (int d = 0; d < 32; ++d) s += __builtin_bit_cast(float, (unsigned)qr[d] << 16) * sNV[dq + d];
            sQP[tid] = s; }
        __syncthreads();
        { const int row = tid >> 2, seg = tid & 3; const float wi = sWI[row]; LAS v4u* p = (LAS v4u*)(qt + row * ML_TS + seg * 64);
#pragma unroll
          for (int i = 0; i < 4; ++i) { const v4u x = p[i]; v4u y; y.x = pk2(bf_lo(x.x) * wi, bf_hi(x.x) * wi); y.y = pk2(bf_lo(x.y) * wi, bf_hi(x.y) * wi); y.z = pk2(bf_lo(x.z) * wi, bf_hi(x.z) * wi); y.w = pk2(bf_lo(x.w) * wi, bf_hi(x.w) * wi); p[i] = y; } }
        f32x16 num[2][2];
#pragma unroll
        for (int hf = 0; hf < 2; ++hf) {
            if (hf) __syncthreads();
            ml_load_tile<128>(T1 + (size_t)tok0 * D + hh * ML_DV + 128 * hf, D, vt, ML_TS, tid);
            ml_load_tile<128>(Ct + (size_t)u * 32768 + (size_t)(128 * hf) * ML_DK, ML_DK, ct, ML_TS, tid);
            __syncthreads();
            num[hf][0] = (f32x16){}; num[hf][1] = (f32x16){};
            for (int ks = 0; ks < 2 * (tb + 1); ++ks) { const bf16x8 b = frag_row(kt, ML_TS, 32 * tb, 16 * ks, lane);
#pragma unroll
                for (int i = 0; i < 2; ++i) num[hf][i] = MFMA32(frag_tr_nat(vt, ML_TS, 16 * ks, 32 * (2 * wh + i), lane, trv), b, num[hf][i]); }
#pragma unroll
            for (int ks = 0; ks < 8; ++ks) { const bf16x8 b = frag_row(qt, ML_TS, 32 * tb, 16 * ks, lane);
#pragma unroll
                for (int i = 0; i < 2; ++i) num[hf][i] = MFMA32(frag_row(ct, ML_TS, 32 * (2 * wh + i), 16 * ks, lane), b, num[hf][i]); }
        }
        float den = sDS[t] + sDS[128 + t] + sWI[t] * ((sQP[t] + sQP[128 + t]) + (sQP[256 + t] + sQP[384 + t])); den = fmaxf(fabsf(den), sEM[t]); const float inv = 1.0f / den; float sq = 0.f;
#pragma unroll
        for (int hf = 0; hf < 2; ++hf)
#pragma unroll
            for (int i = 0; i < 2; ++i)
#pragma unroll
                for (int r = 0; r < 16; ++r) { num[hf][i][r] *= inv; sq += num[hf][i][r] * num[hf][i][r]; }
        sq = hsum(sq);
        if (hi == 0) sSQ[wh * 128 + t] = sq;
        __syncthreads();
        const float rinv = 1.0f / sqrtf((sSQ[t] + sSQ[128 + t]) * (1.0f / ML_DV) + EPS);
#pragma unroll
        for (int hf = 0; hf < 2; ++hf)
#pragma unroll
            for (int i = 0; i < 2; ++i)
#pragma unroll
                for (int g = 0; g < 4; ++g) { const int col = hh * ML_DV + 128 * hf + 32 * (2 * wh + i) + 8 * g + 4 * hi; bf16* op = T2 + (size_t)(tok0 + t) * D + col;
                    const v2u ow = *(const v2u*)op; const f32x4 hg = *(const f32x4*)(hgain + col);
                    const float o0 = bf_lo(ow.x), o1 = bf_hi(ow.x), o2 = bf_lo(ow.y), o3 = bf_hi(ow.y);
                    const float y0 = num[hf][i][4 * g] * rinv * hg[0] * __builtin_amdgcn_rcpf(1.0f + __expf(-o0)), y1 = num[hf][i][4 * g + 1] * rinv * hg[1] * __builtin_amdgcn_rcpf(1.0f + __expf(-o1));
                    const float y2 = num[hf][i][4 * g + 2] * rinv * hg[2] * __builtin_amdgcn_rcpf(1.0f + __expf(-o2)), y3 = num[hf][i][4 * g + 3] * rinv * hg[3] * __builtin_amdgcn_rcpf(1.0f + __expf(-o3));
                    *(v2u*)op = (v2u){pk2(y0, y1), pk2(y2, y3)}; }
        __syncthreads();
    }
}

constexpr int KT_S = 144, VT_S = 192;
constexpr int MB_VT_OFF = 256 * KT_S;
__device__ __forceinline__ bf16* po_slot(Frame& F, int slot) { return (slot < 2) ? (bf16*)F.out + (size_t)slot * S * D : WSP(bf16, WS_PO2); }
__device__ __forceinline__ int list_base(int h, int j) { return h * LIST_HEAD_CAP + 256 * (63 * j - (j * (j - 1)) / 2); }
__device__ __forceinline__ void mb_load_kv(const bf16* Kg, const bf16* Vg, int j, int h, LAS unsigned char* lds, int tid) {
    const int row = tid >> 1, half = tid & 1; const size_t go = (size_t)(j * MB_BLK + row) * D + h * DH + half * 32;
    const v4u* ks = (const v4u*)(Kg + go); const v4u* vs = (const v4u*)(Vg + go);
    LAS v4u* kd = (LAS v4u*)(lds + row * KT_S + half * 64); LAS v4u* vd = (LAS v4u*)(lds + MB_VT_OFF + row * VT_S + half * 64);
#pragma unroll
    for (int i = 0; i < 4; ++i) { kd[i] = ks[i]; vd[i] = vs[i]; }
}
constexpr float MB_THR = 6.0f;
template <bool CAUSAL> __device__ __forceinline__ void mb_attend(LAS const unsigned char* kt, LAS const unsigned char* vt, const bf16x8 (&qf)[4], int nkb, int lane, f32x16& o0, f32x16& o1, float& m, float& lsum) {
    const int hi = lane >> 5, qn = lane & 31, trv = tr_lane_off(lane, VT_S);
    o0 = (f32x16){}; o1 = (f32x16){}; m = -1.0e30f; lsum = 0.f;
    bf16x8 kf[4];
#pragma unroll
    for (int s = 0; s < 4; ++s) kf[s] = frag_row(kt, KT_S, 0, 16 * s, lane);
    for (int kb = 0; kb < nkb; ++kb) {
        f32x16 st = {}, st2 = {};
        st = MFMA32(kf[0], qf[0], st); st2 = MFMA32(kf[1], qf[1], st2); st = MFMA32(kf[2], qf[2], st); st2 = MFMA32(kf[3], qf[3], st2);
        const int kn = (kb + 1 < nkb) ? kb + 1 : kb;
#pragma unroll
        for (int s = 0; s < 4; ++s) kf[s] = frag_row(kt, KT_S, 32 * kn, 16 * s, lane);
        const bf16x8 v00 = frag_tr_acc(vt, VT_S, 32 * kb, 0, lane, trv), v01 = frag_tr_acc(vt, VT_S, 32 * kb, 32, lane, trv), v10 = frag_tr_acc(vt, VT_S, 32 * kb + 16, 0, lane, trv), v11 = frag_tr_acc(vt, VT_S, 32 * kb + 16, 32, lane, trv);
        __builtin_amdgcn_sched_barrier(0);
        st += st2;
        if (CAUSAL) { if (kb == nkb - 1) {
#pragma unroll
            for (int r = 0; r < 16; ++r) if (crow(r, hi) > qn) st[r] = -1.0e30f; } }
        const float mb = hmax(max16(st));
        if (__any(mb > m + MB_THR)) { const float mn = fmaxf(m, mb), alpha = ex2(m - mn); m = mn; lsum *= alpha; o0 *= alpha; o1 *= alpha; }
#pragma unroll
        for (int r = 0; r < 16; ++r) st[r] = ex2(st[r] - m);
        lsum += sum16(st);
        const bf16x8 p0 = pack_acc(st, 0), p1 = pack_acc(st, 1);
        o0 = MFMA32(v00, p0, o0); o1 = MFMA32(v01, p0, o1); o0 = MFMA32(v10, p1, o0); o1 = MFMA32(v11, p1, o1);
    }
}
struct MbTile { f32x16 o0, o1; float m, l; };
__device__ __forceinline__ void mb_softmax_step(f32x16& st, MbTile& T) {
    const float mb = hmax(max16(st));
    if (__any(mb > T.m + MB_THR)) { const float mn = fmaxf(T.m, mb), alpha = ex2(T.m - mn); T.m = mn; T.l *= alpha; T.o0 *= alpha; T.o1 *= alpha; }
#pragma unroll
    for (int r = 0; r < 16; ++r) st[r] = ex2(st[r] - T.m);
    T.l += sum16(st);
}
__device__ __forceinline__ void mb_attend2(LAS const unsigned char* kt, LAS const unsigned char* vt, const bf16x8 (&qa)[4], const bf16x8 (&qb)[4], int nkb, int lane, MbTile& A, MbTile& B) {
    const int trv = tr_lane_off(lane, VT_S);
    A.o0 = (f32x16){}; A.o1 = (f32x16){}; A.m = -1.0e30f; A.l = 0.f; B.o0 = (f32x16){}; B.o1 = (f32x16){}; B.m = -1.0e30f; B.l = 0.f;
    bf16x8 kf[4];
#pragma unroll
    for (int s = 0; s < 4; ++s) kf[s] = frag_row(kt, KT_S, 0, 16 * s, lane);
    for (int kb = 0; kb < nkb; ++kb) {
        f32x16 sa = {}, sb = {};
#pragma unroll
        for (int s = 0; s < 4; ++s) { sa = MFMA32(kf[s], qa[s], sa); sb = MFMA32(kf[s], qb[s], sb); }
        const int kn = (kb + 1 < nkb) ? kb + 1 : kb;
#pragma unroll
        for (int s = 0; s < 4; ++s) kf[s] = frag_row(kt, KT_S, 32 * kn, 16 * s, lane);
        const bf16x8 v00 = frag_tr_acc(vt, VT_S, 32 * kb, 0, lane, trv), v01 = frag_tr_acc(vt, VT_S, 32 * kb, 32, lane, trv), v10 = frag_tr_acc(vt, VT_S, 32 * kb + 16, 0, lane, trv), v11 = frag_tr_acc(vt, VT_S, 32 * kb + 16, 32, lane, trv);
        __builtin_amdgcn_sched_barrier(0);
        mb_softmax_step(sa, A); mb_softmax_step(sb, B);
        const bf16x8 pa0 = pack_acc(sa, 0), pb0 = pack_acc(sb, 0), pa1 = pack_acc(sa, 1), pb1 = pack_acc(sb, 1);
        A.o0 = MFMA32(v00, pa0, A.o0); B.o0 = MFMA32(v00, pb0, B.o0); A.o1 = MFMA32(v01, pa0, A.o1); B.o1 = MFMA32(v01, pb0, B.o1);
        A.o0 = MFMA32(v10, pa1, A.o0); B.o0 = MFMA32(v10, pb1, B.o0); A.o1 = MFMA32(v11, pa1, A.o1); B.o1 = MFMA32(v11, pb1, B.o1);
    }
}
__device__ __forceinline__ void mb_store_partial(Frame& F, float* lse, const MbTile& T, bool valid, int q, int slot, int h, int hi) {
    const float ls = hsum(T.l), inv = 1.0f / ls;
    if (valid) { bf16* op = po_slot(F, slot) + (size_t)q * D + h * DH + 4 * hi;
#pragma unroll
        for (int g = 0; g < 4; ++g) { *(v2u*)(op + 8 * g) = (v2u){pk2(T.o0[4 * g] * inv, T.o0[4 * g + 1] * inv), pk2(T.o0[4 * g + 2] * inv, T.o0[4 * g + 3] * inv)};
                                      *(v2u*)(op + 32 + 8 * g) = (v2u){pk2(T.o1[4 * g] * inv, T.o1[4 * g + 1] * inv), pk2(T.o1[4 * g + 2] * inv, T.o1[4 * g + 3] * inv)}; }
        if (hi == 0) lse[((size_t)q * NHEAD + h) * 4 + slot] = T.m + lg2(ls); }
}
__device__ __forceinline__ void top3_insert(float g, int j, float& v0, float& v1, float& v2, int& i0, int& i1, int& i2) {
    const bool b0 = (g > v0) || (g == v0 && j < i0), b1 = (g > v1) || (g == v1 && j < i1), b2 = (g > v2) || (g == v2 && j < i2);
    const float n2 = b1 ? v1 : (b2 ? g : v2), n1 = b0 ? v0 : (b1 ? g : v1), n0 = b0 ? g : v0;
    const int m2 = b1 ? i1 : (b2 ? j : i2), m1 = b0 ? i0 : (b1 ? j : i1), m0 = b0 ? j : i0;
    v0 = n0; v1 = n1; v2 = n2; i0 = m0; i1 = m1; i2 = m2;
}
__device__ __forceinline__ void route_tile(const bf16* Qg, float* lse, LAS const unsigned char* kh, LAS const unsigned char* kl, LAS int* cntl, int tbase, int h, int cur, int lane, unsigned& sel, unsigned& rk01, unsigned& rk2) {
    const int hi = lane >> 5, qn = lane & 31, t = tbase + qn; const bf16* qp = Qg + (size_t)t * D + h * DH + 8 * hi; bf16x8 qf[4];
#pragma unroll
    for (int s = 0; s < 4; ++s) qf[s] = *(const bf16x8*)(qp + 16 * s);
    float v0 = -3.0e38f, v1 = -3.0e38f, v2 = -3.0e38f; int i0 = 255, i1 = 255, i2 = 255;
#pragma unroll
    for (int jt = 0; jt < 2; ++jt) if (32 * jt < cur) { f32x16 g = {};
#pragma unroll
        for (int s = 0; s < 4; ++s) { g = MFMA32(frag_row(kh, KT_S, 32 * jt, 16 * s, lane), qf[s], g); g = MFMA32(frag_row(kl, KT_S, 32 * jt, 16 * s, lane), qf[s], g); }
#pragma unroll
        for (int r = 0; r < 16; ++r) { const int j = 32 * jt + crow(r, hi); top3_insert((j < cur) ? g[r] : -3.0e38f, (j < cur) ? j : 255, v0, v1, v2, i0, i1, i2); } }
    { const float p0 = __shfl_xor(v0, 32), p1 = __shfl_xor(v1, 32), p2 = __shfl_xor(v2, 32); const int q0 = __shfl_xor(i0, 32), q1 = __shfl_xor(i1, 32), q2 = __shfl_xor(i2, 32);
      top3_insert(p0, q0, v0, v1, v2, i0, i1, i2); top3_insert(p1, q1, v0, v1, v2, i0, i1, i2); top3_insert(p2, q2, v0, v1, v2, i0, i1, i2); }
    int r0 = 0, r1 = 0, r2 = 0;
    if (hi == 0) { if (i0 != 255) r0 = __hip_atomic_fetch_add(cntl + i0, 1, __ATOMIC_RELAXED, __HIP_MEMORY_SCOPE_WORKGROUP);
                   if (i1 != 255) r1 = __hip_atomic_fetch_add(cntl + i1, 1, __ATOMIC_RELAXED, __HIP_MEMORY_SCOPE_WORKGROUP);
                   if (i2 != 255) r2 = __hip_atomic_fetch_add(cntl + i2, 1, __ATOMIC_RELAXED, __HIP_MEMORY_SCOPE_WORKGROUP);
                   *(f32x4*)(lse + ((size_t)t * NHEAD + h) * 4) = (f32x4){-1.0e30f, -1.0e30f, -1.0e30f, -1.0e30f}; }
    sel = (unsigned)i0 | ((unsigned)i1 << 8) | ((unsigned)i2 << 16); rk01 = (unsigned)r0 | ((unsigned)r1 << 16); rk2 = (unsigned)r2;
}
__device__ __forceinline__ void route_emit(unsigned short* list, LAS const int* basel, int h, int t, unsigned sel, unsigned rk01, unsigned rk2) {
    const int i0 = sel & 255u, i1 = (sel >> 8) & 255u, i2 = (sel >> 16) & 255u;
    if (i0 != 255) list[(size_t)list_base(h, i0) + basel[i0] + (int)(rk01 & 0xffffu)] = (unsigned short)(t | (0 << 14));
    if (i1 != 255) list[(size_t)list_base(h, i1) + basel[i1] + (int)(rk01 >> 16)] = (unsigned short)(t | (1 << 14));
    if (i2 != 255) list[(size_t)list_base(h, i2) + basel[i2] + (int)rk2] = (unsigned short)(t | (2 << 14));
}
__device__ __forceinline__ void moba_route(Frame& F) {
    const bf16* Qg = WSP(bf16, WS_T0); const float* km = WSP(float, WS_KMEAN); unsigned short* list = WSP(unsigned short, WS_LIST); int* cnt = WSP(int, WS_CNT); float* lse = WSP(float, WS_LSE);
    LAS unsigned char* kh = F.lds; LAS unsigned char* kl = F.lds + 9216;
    LAS int* cntl = (LAS int*)(F.lds + 18432); LAS int* basel = cntl + 64;
    const int tid = F.tid, lane = F.lane, w = F.wave, hi = lane >> 5, qn = lane & 31;
    for (int u = blockIdx.x, k = 0; u < NHEAD * (S / 512); u += F.G, ++k) { const int h = u >> 5, t0 = ((k & 1) ? 31 - (u & 31) : (u & 31)) * 512;
        __syncthreads();
        { const int j = tid >> 3, d8 = (tid & 7) * 8; const f32x4* src = (const f32x4*)(km + ((size_t)h * 64 + j) * 64 + d8); const f32x4 a = src[0], b = src[1]; float x[8] = {a[0], a[1], a[2], a[3], b[0], b[1], b[2], b[3]}; unsigned hw[4], lw[4];
#pragma unroll
          for (int i = 0; i < 4; ++i) { hw[i] = pk2(x[2 * i], x[2 * i + 1]); lw[i] = pk2(x[2 * i] - bf_lo(hw[i]), x[2 * i + 1] - bf_hi(hw[i])); }
          *(LAS v4u*)(kh + j * KT_S + d8 * 2) = (v4u){hw[0], hw[1], hw[2], hw[3]}; *(LAS v4u*)(kl + j * KT_S + d8 * 2) = (v4u){lw[0], lw[1], lw[2], lw[3]}; }
        if (tid < 64) cntl[tid] = 0;
        __syncthreads();
        const int cur = __builtin_amdgcn_readfirstlane((t0 + 64 * w) >> 8);
        unsigned selA, selB, rkA0, rkA1, rkB0, rkB1;
        route_tile(Qg, lse, kh, kl, cntl, t0 + 64 * w, h, cur, lane, selA, rkA0, rkA1);
        route_tile(Qg, lse, kh, kl, cntl, t0 + 64 * w + 32, h, cur, lane, selB, rkB0, rkB1);
        __syncthreads();
        if (tid < 64) { const int c = cntl[tid]; basel[tid] = (c > 0) ? __hip_atomic_fetch_add(cnt + h * 64 + tid, c, __ATOMIC_RELAXED, __HIP_MEMORY_SCOPE_AGENT) : 0; }
        __syncthreads();
        if (hi == 0) { route_emit(list, basel, h, t0 + 64 * w + qn, selA, rkA0, rkA1); route_emit(list, basel, h, t0 + 64 * w + 32 + qn, selB, rkB0, rkB1); }
    }
}
struct MbSeg { int b, ta, tb; };
__device__ __forceinline__ bool mb_next_seg(LAS const int* pre, LAS const int* cnt, int c0, int c1, int bfrom, MbSeg& sg) {
    constexpr int LC = 22;
    for (int b = bfrom; b < 1024 && pre[b] < c1; ++b) { const int nt = (cnt[b] + 31) >> 5; if (nt == 0) continue;
        const int ta = max(0, c0 - pre[b] - LC), tb = min(nt, c1 - pre[b] - LC); if (tb > ta) { sg.b = b; sg.ta = ta; sg.tb = tb; return true; } }
    return false;
}
__device__ __forceinline__ void mb_kv_request(const bf16* Kg, const bf16* Vg, int j, int h, int tid, v4u (&kr)[4], v4u (&vr)[4]) {
    const int row = tid >> 1, half = tid & 1; const size_t go = (size_t)(j * MB_BLK + row) * D + h * DH + half * 32; const v4u* ks = (const v4u*)(Kg + go); const v4u* vs = (const v4u*)(Vg + go);
#pragma unroll
    for (int i = 0; i < 4; ++i) { kr[i] = ks[i]; vr[i] = vs[i]; }
}
__device__ __forceinline__ void mb_kv_commit(LAS unsigned char* lds, int tid, const v4u (&kr)[4], const v4u (&vr)[4]) {
    const int row = tid >> 1, half = tid & 1; LAS v4u* kd = (LAS v4u*)(lds + row * KT_S + half * 64); LAS v4u* vd = (LAS v4u*)(lds + MB_VT_OFF + row * VT_S + half * 64);
#pragma unroll
    for (int i = 0; i < 4; ++i) { kd[i] = kr[i]; vd[i] = vr[i]; }
}
struct MbEnt { unsigned ea, eb; };
__device__ __forceinline__ MbEnt mb_entries(const unsigned short* list, size_t lb, int tp, int tb, int n, int qn) {
    const int ia = 32 * tp + qn, ib = ia + 32; const bool va = ia < n, vb = (tp + 1 < tb) && (ib < n); MbEnt e;
    e.ea = (unsigned)list[lb + (va ? ia : 32 * tp)] | (va ? 0u : 0x80000000u); e.eb = (unsigned)list[lb + (vb ? ib : 32 * tp)] | (vb ? 0u : 0x80000000u); return e;
}
__device__ __forceinline__ void mb_qfrags(const bf16* Qg, const MbEnt& e, int h, int hi, bf16x8 (&qa)[4], bf16x8 (&qb)[4]) {
    const bf16* pa = Qg + (size_t)(e.ea & 0x3fffu) * D + h * DH + 8 * hi; const bf16* pb = Qg + (size_t)(e.eb & 0x3fffu) * D + h * DH + 8 * hi;
#pragma unroll
    for (int s = 0; s < 4; ++s) { qa[s] = *(const bf16x8*)(pa + 16 * s); qb[s] = *(const bf16x8*)(pb + 16 * s); }
}
__device__ __forceinline__ void moba_selected(Frame& F) {
    const bf16* Qg = WSP(bf16, WS_T0); const bf16* Kg = WSP(bf16, WS_T1); const bf16* Vg = WSP(bf16, WS_T2);
    const unsigned short* list = WSP(unsigned short, WS_LIST); const int* cnt = WSP(int, WS_CNT); float* lse = WSP(float, WS_LSE);
    LAS int* pre = (LAS int*)(F.lds + 98304);
    const int tid = F.tid, lane = F.lane, w = F.wave, hi = lane >> 5, qn = lane & 31;
    constexpr int LC = 22;
    LAS int* cntl = pre + 1088;
    { if (w == 0) { int loc[16]; int s = 0;
#pragma unroll
            for (int i = 0; i < 16; ++i) { const int c = cnt[lane * 16 + i]; cntl[lane * 16 + i] = c; const int nt = (c + 31) >> 5; loc[i] = nt ? nt + LC : 0; s += loc[i]; }
            int inc = s;
#pragma unroll
            for (int o = 1; o < 64; o <<= 1) { const int t = __shfl_up(inc, o); if (lane >= o) inc += t; }
            int run = inc - s;
#pragma unroll
            for (int i = 0; i < 16; ++i) { pre[lane * 16 + i] = run; run += loc[i]; }
            if (lane == 63) pre[1024] = run; }
        __syncthreads(); }
    const int ctot = pre[1024], share = (ctot + F.G - 1) / F.G, c0 = blockIdx.x * share, c1 = min(ctot, c0 + share);
    MbSeg sg; bool have_seg = false;
    if (c0 < c1) { int lo = 0, hb_ = 1024; while (hb_ - lo > 1) { const int mid = (lo + hb_) >> 1; if (pre[mid] <= c0) lo = mid; else hb_ = mid; }
        have_seg = mb_next_seg(pre, cntl, c0, c1, lo, sg); }
    while (have_seg) {
        const int h = sg.b >> 6, j = sg.b & 63, n = cntl[sg.b], tb = sg.tb; const size_t lb = (size_t)list_base(h, j);
        MbSeg nsg; const bool have_next = mb_next_seg(pre, cntl, c0, c1, sg.b + 1, nsg);
        int tp = sg.ta + 2 * w; MbEnt e0 = {0u, 0u}, e1 = {0u, 0u};
        if (tp < tb) e0 = mb_entries(list, lb, tp, tb, n, qn);
        if (tp + 2 * NWAVES < tb) e1 = mb_entries(list, lb, tp + 2 * NWAVES, tb, n, qn);
        __syncthreads();
        mb_load_kv(Kg, Vg, j, h, F.lds, tid);
        __syncthreads();
        while (tp < tb) {
            const int tp1 = tp + 2 * NWAVES, tp2 = tp + 4 * NWAVES; MbEnt e2 = {0u, 0u};
            if (tp2 < tb) e2 = mb_entries(list, lb, tp2, tb, n, qn);
            bf16x8 qa[4], qb[4]; mb_qfrags(Qg, e0, h, hi, qa, qb);
            MbTile A, B;
            mb_attend2(F.lds, F.lds + MB_VT_OFF, qa, qb, 8, lane, A, B);
            mb_store_partial(F, lse, A, !(e0.ea >> 31), e0.ea & 0x3fffu, (e0.ea >> 14) & 3u, h, hi); mb_store_partial(F, lse, B, !(e0.eb >> 31), e0.eb & 0x3fffu, (e0.eb >> 14) & 3u, h, hi);
            e0 = e1; e1 = e2; tp = tp1;
        }
        sg = nsg; have_seg = have_next;
    }
    __syncthreads();
}
__device__ __forceinline__ void moba_own_merge(Frame& F) {
    bf16* Qg = WSP(bf16, WS_T0); const bf16* Kg = WSP(bf16, WS_T1); const bf16* Vg = WSP(bf16, WS_T2); const float* lse = WSP(float, WS_LSE);
    const int tid = F.tid, lane = F.lane, w = F.wave, hi = lane >> 5, qn = lane & 31;
    int u = blockIdx.x; v4u kr[4], vr[4]; bf16x8 qn_[4];
    if (u < NHEAD * MB_NB) { mb_kv_request(Kg, Vg, u >> 4, u & 15, tid, kr, vr); const bf16* qp = Qg + (size_t)((u >> 4) * MB_BLK + 32 * w + qn) * D + (u & 15) * DH + 8 * hi;
#pragma unroll
        for (int s = 0; s < 4; ++s) qn_[s] = *(const bf16x8*)(qp + 16 * s); }
    for (; u < NHEAD * MB_NB; u += F.G) { const int h = u & 15, j = u >> 4; const int un = u + F.G;
        __syncthreads();
        mb_kv_commit(F.lds, tid, kr, vr);
        bf16x8 qf[4];
#pragma unroll
        for (int s = 0; s < 4; ++s) qf[s] = qn_[s];
        __syncthreads();
        if (un < NHEAD * MB_NB) { mb_kv_request(Kg, Vg, un >> 4, un & 15, tid, kr, vr); const bf16* qp = Qg + (size_t)((un >> 4) * MB_BLK + 32 * w + qn) * D + (un & 15) * DH + 8 * hi;
#pragma unroll
            for (int s = 0; s < 4; ++s) qn_[s] = *(const bf16x8*)(qp + 16 * s); }
        const int t = j * MB_BLK + 32 * w + qn; bf16* qp = Qg + (size_t)t * D + h * DH;
        const f32x4 lw = *(const f32x4*)(lse + ((size_t)t * NHEAD + h) * 4);
        v2u pr[3][8];
#pragma unroll
        for (int s = 0; s < 3; ++s) { const bool on = lw[s] > -1.0e29f; const bf16* pp = po_slot(F, s) + (size_t)t * D + h * DH + 4 * hi;
#pragma unroll
            for (int g = 0; g < 4; ++g) { pr[s][g] = on ? *(const v2u*)(pp + 8 * g) : (v2u){0u, 0u}; pr[s][4 + g] = on ? *(const v2u*)(pp + 32 + 8 * g) : (v2u){0u, 0u}; } }
        f32x16 o0, o1; float m, ls;
        mb_attend<true>(F.lds, F.lds + MB_VT_OFF, qf, w + 1, lane, o0, o1, m, ls);
        ls = hsum(ls);
        const float lown = m + lg2(ls);
        const float W = fmaxf(fmaxf(lown, lw[0]), fmaxf(lw[1], lw[2]));
        const float cown = ex2(lown - W); float cs[3];
#pragma unroll
        for (int s = 0; s < 3; ++s) cs[s] = (lw[s] > -1.0e29f) ? ex2(lw[s] - W) : 0.f;
        const float rden = 1.0f / (cown + cs[0] + cs[1] + cs[2]); const float co = cown * rden / ls;
        o0 *= co; o1 *= co;
#pragma unroll
        for (int s = 0; s < 3; ++s) { const float c_ = cs[s] * rden;
#pragma unroll
            for (int g = 0; g < 4; ++g) { const v2u a = pr[s][g], b = pr[s][4 + g];
                o0[4 * g] += c_ * bf_lo(a.x); o0[4 * g + 1] += c_ * bf_hi(a.x); o0[4 * g + 2] += c_ * bf_lo(a.y); o0[4 * g + 3] += c_ * bf_hi(a.y);
                o1[4 * g] += c_ * bf_lo(b.x); o1[4 * g + 1] += c_ * bf_hi(b.x); o1[4 * g + 2] += c_ * bf_lo(b.y); o1[4 * g + 3] += c_ * bf_hi(b.y); } }
#pragma unroll
        for (int g = 0; g < 4; ++g) { *(v2u*)(qp + 4 * hi + 8 * g) = (v2u){pk2(o0[4 * g], o0[4 * g + 1]), pk2(o0[4 * g + 2], o0[4 * g + 3])};
                                      *(v2u*)(qp + 4 * hi + 32 + 8 * g) = (v2u){pk2(o1[4 * g], o1[4 * g + 1]), pk2(o1[4 * g + 2], o1[4 * g + 3])}; }
    }
    __syncthreads();
}

__device__ __forceinline__ void up8(const v4u x, float (&o)[8]) { o[0] = bf_lo(x.x); o[1] = bf_hi(x.x); o[2] = bf_lo(x.y); o[3] = bf_hi(x.y); o[4] = bf_lo(x.z); o[5] = bf_hi(x.z); o[6] = bf_lo(x.w); o[7] = bf_hi(x.w); }
__device__ __forceinline__ void ld8(const bf16* p, float (&o)[8]) { const v4u x = *(const v4u*)p; o[0] = bf_lo(x.x); o[1] = bf_hi(x.x); o[2] = bf_lo(x.y); o[3] = bf_hi(x.y); o[4] = bf_lo(x.z); o[5] = bf_hi(x.z); o[6] = bf_lo(x.w); o[7] = bf_hi(x.w); }
__device__ __forceinline__ void conv_phase(Frame& F) {
    bf16* Bg = WSP(bf16, WS_T0); const bf16* Zg = WSP(bf16, WS_T1); const float* cw = F.in[10];
    const int tid = F.tid, cg = tid & 127, rp = tid >> 7;
    float w0[8], w1[8], w2[8];
#pragma unroll
    for (int e = 0; e < 8; ++e) { w0[e] = cw[cg * 8 + e]; w1[e] = cw[D + cg * 8 + e]; w2[e] = cw[2 * D + cg * 8 + e]; }
    for (int u = blockIdx.x; u < S / 64; u += F.G) { const int r0 = u * 64 + rp * 16; float zm2[8], zm1[8];
        if (r0 >= 2) { ld8(Zg + (size_t)(r0 - 2) * D + cg * 8, zm2); ld8(Zg + (size_t)(r0 - 1) * D + cg * 8, zm1); }
        else {
#pragma unroll
            for (int e = 0; e < 8; ++e) { zm2[e] = 0.f; zm1[e] = 0.f; } }
        for (int rb = r0; rb < r0 + 16; rb += 8) { v4u zz[8], bb[8];
#pragma unroll
            for (int i = 0; i < 8; ++i) { zz[i] = *(const v4u*)(Zg + (size_t)(rb + i) * D + cg * 8); bb[i] = *(const v4u*)(Bg + (size_t)(rb + i) * D + cg * 8); }
#pragma unroll
            for (int i = 0; i < 8; ++i) { float z[8], b[8], y[8]; up8(zz[i], z); up8(bb[i], b);
#pragma unroll
                for (int e = 0; e < 8; ++e) { y[e] = b[e] * (w0[e] * zm2[e] + w1[e] * zm1[e] + w2[e] * z[e]); zm2[e] = zm1[e]; zm1[e] = z[e]; }
                *(v4u*)(Bg + (size_t)(rb + i) * D + cg * 8) = (v4u){pk2(y[0], y[1]), pk2(y[2], y[3]), pk2(y[4], y[5]), pk2(y[6], y[7])}; } }
    }
}

constexpr float SB_STOP = 64.0f;
__device__ __forceinline__ void sb_load(const bf16* Kg, const bf16* Vg, int kb, int head, int lane, bf16x8 (&k)[4], v4u (&v)[4]) {
    const bf16* kp = Kg + (size_t)(kb * 32 + (lane & 31)) * D + head * DH + 8 * (lane >> 5); const v4u* vs = (const v4u*)(Vg + (size_t)(kb * 32 + (lane >> 1)) * D + head * DH + 32 * (lane & 1));
#pragma unroll
    for (int s = 0; s < 4; ++s) { k[s] = *(const bf16x8*)(kp + 16 * s); v[s] = vs[s]; }
}
__device__ __forceinline__ bool sb_block(const bf16x8 (&kf)[4], const v4u (&vv)[4], const bf16x8 (&qf)[4], LAS unsigned char* vt, bool diag, int lane, int trv, f32x16& o0, f32x16& o1, float& R) {
    const int hi = lane >> 5, qn = lane & 31;
    { LAS v4u* vd = (LAS v4u*)(vt + (lane >> 1) * VT_S + (lane & 1) * 64);
#pragma unroll
      for (int i = 0; i < 4; ++i) vd[i] = vv[i]; }
    f32x16 st = {};
#pragma unroll
    for (int s = 0; s < 4; ++s) st = MFMA32(kf[s], qf[s], st);
    float sp[16];
#pragma unroll
    for (int r = 0; r < 16; ++r) { st[r] = fminf(st[r], 100.f); sp[r] = lg2(1.0f + ex2(st[r])); }
    if (diag) {
#pragma unroll
        for (int r = 0; r < 16; ++r) if (crow(r, hi) >= qn) sp[r] = 0.f; }
    float ina[16], gt[4];
#pragma unroll
    for (int g = 0; g < 4; ++g) { const float s3 = sp[4 * g + 3], s2 = sp[4 * g + 2] + s3, s1 = sp[4 * g + 1] + s2, s0 = sp[4 * g] + s1;
        ina[4 * g + 3] = 0.f; ina[4 * g + 2] = s3; ina[4 * g + 1] = s2; ina[4 * g] = s1; gt[g] = s0; }
    float tail = 0.f, later[4];
#pragma unroll
    for (int g = 3; g >= 0; --g) { float lo_, hi_; halves(gt[g], lo_, hi_); later[g] = hi ? tail : (hi_ + tail); tail += lo_ + hi_; }
#pragma unroll
    for (int r = 0; r < 16; ++r) st[r] = ex2(st[r] - sp[r] - (R + later[r >> 2] + ina[r]));
    if (diag) {
#pragma unroll
        for (int r = 0; r < 16; ++r) if (crow(r, hi) >= qn) st[r] = 0.f; }
    R += tail;
#pragma unroll
    for (int s2 = 0; s2 < 2; ++s2) { const bf16x8 pf = pack_acc(st, s2);
        o0 = MFMA32(frag_tr_acc(vt, VT_S, 16 * s2, 0, lane, trv), pf, o0);
        o1 = MFMA32(frag_tr_acc(vt, VT_S, 16 * s2, 32, lane, trv), pf, o1); }
    return __all(R > SB_STOP);
}
__device__ __forceinline__ void sb_phase(Frame& F) {
    bf16* Qg = WSP(bf16, WS_T0); const bf16* Kg = WSP(bf16, WS_T1); const bf16* Vg = WSP(bf16, WS_T2);
    const int lane = F.lane, hi = lane >> 5, qn = lane & 31;
    LAS unsigned char* vt = F.lds + AUX_OFF + F.wave * 6144;
    const int trv = tr_lane_off(lane, VT_S);
    for (int u = blockIdx.x * NWAVES + F.wave; u < NHEAD * (S / 32); u += F.G * NWAVES) { const int head = u & 15, qb = u >> 4, t = qb * 32 + qn;
        bf16* qp = Qg + (size_t)t * D + head * DH; bf16x8 qf[4];
#pragma unroll
        for (int s = 0; s < 4; ++s) qf[s] = *(const bf16x8*)(qp + 8 * hi + 16 * s);
        f32x16 o0 = {}, o1 = {}; float R = 0.f;
        bf16x8 kA[4], kB[4], kC[4]; v4u vA[4], vB[4], vC[4]; int kb = qb;
        sb_load(Kg, Vg, kb, head, lane, kA, vA); sb_load(Kg, Vg, kb > 0 ? kb - 1 : 0, head, lane, kB, vB);
        for (;;) {
            sb_load(Kg, Vg, kb > 1 ? kb - 2 : 0, head, lane, kC, vC);
            if (sb_block(kA, vA, qf, vt, kb == qb, lane, trv, o0, o1, R) || kb == 0) break; --kb;
            sb_load(Kg, Vg, kb > 1 ? kb - 2 : 0, head, lane, kA, vA);
            if (sb_block(kB, vB, qf, vt, false, lane, trv, o0, o1, R) || kb == 0) break; --kb;
            sb_load(Kg, Vg, kb > 1 ? kb - 2 : 0, head, lane, kB, vB);
            if (sb_block(kC, vC, qf, vt, false, lane, trv, o0, o1, R) || kb == 0) break; --kb;
        }
#pragma unroll
        for (int g = 0; g < 4; ++g) { *(v2u*)(qp + 4 * hi + 8 * g) = (v2u){pk2(o0[4 * g], o0[4 * g + 1]), pk2(o0[4 * g + 2], o0[4 * g + 3])};
                                      *(v2u*)(qp + 4 * hi + 32 + 8 * g) = (v2u){pk2(o1[4 * g], o1[4 * g + 1]), pk2(o1[4 * g + 2], o1[4 * g + 3])}; }
    }
}

__device__ __forceinline__ void final_norm(Frame& F) {
    const bf16* hb = WSP(bf16, WS_HB); float* out = F.out; const float* ss = WSP(float, WS_SS); const float* fg = F.in[17];
    const int gw = blockIdx.x * NWAVES + F.wave, NGW = F.G * NWAVES, lane = F.lane;
    for (int row = gw; row < S; row += NGW) { const float rs = pg8::row_rs(ss, row); const v2u* hr = (const v2u*)(hb + (size_t)row * D) + lane; f32x4* orow = (f32x4*)(out + (size_t)row * D) + lane;
#pragma unroll
        for (int j = 0; j < 4; ++j) { const v2u x = hr[64 * j]; const f32x4 g = *((const f32x4*)fg + lane + 64 * j);
            orow[64 * j] = (f32x4){bf_lo(x.x) * rs * g[0], bf_hi(x.x) * rs * g[1], bf_lo(x.y) * rs * g[2], bf_hi(x.y) * rs * g[3]}; } }
}
__device__ __forceinline__ void rs_preamble(Frame& F, const pg8::StaticOrder& So, const float* ss) {
    LAS float* rsl = (LAS float*)(F.lds + RSL_OFF); pg8::Unit u;
    for (int i = 0; So.next(i, u); ++i) { if (F.tid < 256) rsl[i * 256 + F.tid] = pg8::row_rs(ss, u.pm * 256 + F.tid); }
    __syncthreads();
}

struct Args { const float* in[18]; float* out; unsigned char* ws; int ph_lo, ph_hi; };
__global__ void __launch_bounds__(NWAVES * 64, 2) hybrid_fwd(Args args) {
    extern __shared__ __attribute__((aligned(16))) unsigned char lds[];
    Frame F;
    F.lds = (LAS unsigned char*)lds;
    F.MISC = (volatile LAS unsigned*)(F.lds + MISC_OFF);
    F.tid = threadIdx.x; F.lane = F.tid & 63; F.wave = __builtin_amdgcn_readfirstlane(F.tid >> 6);
    F.G = gridDim.x; F.ws = args.ws; F.out = args.out;
#pragma unroll
    for (int i = 0; i < 18; ++i) F.in[i] = args.in[i];
    F.ctl = (gu32*)(args.ws + WS_CTL);
    for (int u = F.tid; u < (LDS_BYTES - MISC_OFF) / 4; u += NWAVES * 64) ((LAS unsigned*)(F.lds + MISC_OFF))[u] = 0u;
    __syncthreads();
    XcdBarrier bar; bar.bar = (unsigned*)(F.ctl + CW_BAR); bar.x = 0; bar.st = nullptr;
    if (!MK_PER_PHASE) bar = xcd_barrier_post((unsigned*)(F.ctl + CW_BAR), F.MISC + 8);
    const int lo = args.ph_lo, hi = args.ph_hi;
#define IN(k) (lo <= (k) && (k) < hi)
    const bool pr_on = (PROBE_MASK != 0u) && blockIdx.x == PROBE_BLOCK && F.tid == 0;
    volatile LAS unsigned long long* const prs = (volatile LAS unsigned long long*)(F.lds + MISC_OFF + 64);
    if (pr_on) { prs[0] = __builtin_amdgcn_s_memrealtime(); prs[1] = 0ull; }
#define PSTAMP(k) do { if (pr_on) { const unsigned long long t_ = __builtin_amdgcn_s_memrealtime(); if (!PROBE_PRE && ((PROBE_MASK >> (k)) & 1u)) prs[1] = prs[1] + (t_ - prs[0]); prs[0] = t_; } } while (0)
#define PSTAMP_PRE(k) do { if (PROBE_PRE && pr_on) { const unsigned long long t_ = __builtin_amdgcn_s_memrealtime(); if ((PROBE_MASK >> (k)) & 1u) prs[1] = prs[1] + (t_ - prs[0]); prs[0] = t_; } } while (0)
#define SEAM(k) do { PSTAMP_PRE(k); if (IN(k) && IN((k) + 1)) xcd_barrier(bar); PSTAMP(k); } while (0)
    bf16* const T0 = WSP(bf16, WS_T0); bf16* const T2 = WSP(bf16, WS_T2); bf16* const HB = WSP(bf16, WS_HB); float* const SS = WSP(float, WS_SS); const float* const ROPE = WSP(float, WS_ROPE);
    bf16* const WIN = WSP(bf16, WS_WIN); bf16* const WOUT = WSP(bf16, WS_WOUT);
    LAS unsigned char* const ring = F.lds;
#define GEMM_IN(MODE, NSC, SC0) do { pg8::Gemm g{HB, WIN, S, 3 * D, D}; pg8::StaticOrder So; So.init(S, 3 * D, F.G, (int)blockIdx.x); rs_preamble(F, So, SS); \
        pg8::EpiIn<MODE> E{T0, (const LAS float*)(F.lds + RSL_OFF), ROPE, (NSC), (SC0), WSP(float, WS_KMEAN)}; pg8::gemm_phase<pg8::EpiIn<MODE>, pg8::StaticOrder, true, true>(ring, g, So, E); } while (0)
#define GEMM_OUT(APTR, RESF32) do { pg8::Gemm g{(APTR), WOUT, S, D, D}; pg8::StaticOrder So; So.init(S, D, F.G, (int)blockIdx.x); \
        pg8::EpiRes<RESF32> E{F.in[0], HB, SS}; pg8::gemm_phase<pg8::EpiRes<RESF32>, pg8::StaticOrder, false, true>(ring, g, So, E); } while (0)
#define GEMM_UP(L) do { pg8::Gemm g{HB, ((L) & 1) ? WSP(bf16, WS_WGU1) : WSP(bf16, WS_WGU), S, 2 * FF, D}; pg8::StaticOrder So; So.init(S, 2 * FF, F.G, (int)blockIdx.x); rs_preamble(F, So, SS); \
        pg8::EpiGlu E{T0, FF, (const LAS float*)(F.lds + RSL_OFF)}; pg8::gemm_phase<pg8::EpiGlu, pg8::StaticOrder, true, true>(ring, g, So, E); \
        if ((L) < 3) { const int rem_ = So.nwg % F.G; convert_layer(F, (L) + 1, rem_); } } while (0)
#define GEMM_DOWN(L) do { pg8::Gemm g{T0, ((L) & 1) ? WSP(bf16, WS_WD1) : WSP(bf16, WS_WD), S, D, FF}; pg8::StaticOrder So; So.init(S, D, F.G, (int)blockIdx.x); \
        pg8::EpiRes<false> E{nullptr, HB, SS}; pg8::gemm_phase<pg8::EpiRes<false>, pg8::StaticOrder, false, true>(ring, g, So, E); } while (0)

    if (IN(0)) { if (F.wave < 4) { convert_layer(F, 0, 0); prologue_rows(F); } else { prologue_rows(F); convert_layer(F, 0, 0); } } SEAM(0);
    if (IN(1)) { GEMM_IN(0, 2, 0.08838834764831845f); } SEAM(1);
    if (IN(2)) { mlstm_phase_a(F); } SEAM(2);
    if (IN(3)) { mlstm_phase_scan(F); } SEAM(3);
    if (IN(4)) { mlstm_phase_c(F); } SEAM(4);
    if (IN(5)) { GEMM_OUT(T2, true); } SEAM(5);
    if (IN(6)) { GEMM_UP(0); } SEAM(6);
    if (IN(7)) { GEMM_DOWN(0); } SEAM(7);
    if (IN(8)) { GEMM_IN(1, 4, C2); } SEAM(8);
    if (IN(9)) { moba_route(F); } SEAM(9);
    if (IN(10)) { moba_selected(F); } SEAM(10);
    if (IN(11)) { moba_own_merge(F); } SEAM(11);
    if (IN(12)) { GEMM_OUT(T0, false); } SEAM(12);
    if (IN(13)) { GEMM_UP(1); } SEAM(13);
    if (IN(14)) { GEMM_DOWN(1); } SEAM(14);
    if (IN(15)) { GEMM_IN(2, 0, 1.0f); } SEAM(15);
    if (IN(16)) { conv_phase(F); } SEAM(16);
    if (IN(17)) { GEMM_OUT(T0, false); } SEAM(17);
    if (IN(18)) { GEMM_UP(2); } SEAM(18);
    if (IN(19)) { GEMM_DOWN(2); } SEAM(19);
    if (IN(20)) { GEMM_IN(0, 4, C2); } SEAM(20);
    if (IN(21)) { sb_phase(F); } SEAM(21);
    if (IN(22)) { GEMM_OUT(T0, false); } SEAM(22);
    if (IN(23)) { GEMM_UP(3); } SEAM(23);
    if (IN(24)) { GEMM_DOWN(3); } SEAM(24);
    if (IN(25)) { final_norm(F); } PSTAMP(25);
    if (pr_on) { const unsigned long long t0_ = __builtin_amdgcn_s_memrealtime(), span_ = (unsigned long long)PROBE_MULT * prs[1]; while (__builtin_amdgcn_s_memrealtime() - t0_ < span_) __builtin_amdgcn_s_sleep(8); }
#undef IN
#undef SEAM
}

extern "C" void kernel_launch(void* const* d_in, const int* in_sizes, int n_in, void* d_out, int out_size, void* d_ws, size_t ws_size, hipStream_t stream) {
    static int grid = 0;
    if (grid == 0) {
        if (n_in != 18 || out_size != S * D || ws_size < WS_END) { fprintf(stderr, "kernel_launch: unexpected shapes (n_in %d, out %d, ws %zu)\n", n_in, out_size, ws_size); grid = -1; return; }
        int dev = 0, cus = 0, per_cu = 0;
        if (hipGetDevice(&dev) != hipSuccess || hipDeviceGetAttribute(&cus, hipDeviceAttributeMultiprocessorCount, dev) != hipSuccess) { grid = -1; return; }
        if (hipFuncSetAttribute((const void*)hybrid_fwd, hipFuncAttributeMaxDynamicSharedMemorySize, LDS_BYTES) != hipSuccess) { fprintf(stderr, "kernel_launch: hipFuncSetAttribute failed\n"); grid = -1; return; }
        if (hipOccupancyMaxActiveBlocksPerMultiprocessor(&per_cu, (const void*)hybrid_fwd, NWAVES * 64, LDS_BYTES) != hipSuccess || per_cu < 1) { fprintf(stderr, "kernel_launch: occupancy query says %d blocks per CU\n", per_cu); }
        (void)hipGetLastError();
        grid = cus;
    }
    if (grid < 0) return;
    if (hipMemsetAsync((char*)d_ws + WS_CTL, 0, CTL_ZERO_BYTES, stream) != hipSuccess) return;
    Args a{};
    for (int i = 0; i < 18; ++i) a.in[i] = (const float*)d_in[i];
    a.out = (float*)d_out; a.ws = (unsigned char*)d_ws;
#if MK_PER_PHASE
    for (int p = 0; p < NPHASE; ++p) { a.ph_lo = p; a.ph_hi = p + 1; hipLaunchKernelGGL(hybrid_fwd, dim3(grid), dim3(NWAVES * 64), LDS_BYTES, stream, a); }
#else
    a.ph_lo = 0; a.ph_hi = NPHASE;
    hipLaunchKernelGGL(hybrid_fwd, dim3(grid), dim3(NWAVES * 64), LDS_BYTES, stream, a);
#endif
}
```

```cpp
#include <hip/hip_runtime.h>
#include <cstdio>
#include <cstdint>
namespace pg8 {
#define PG8_LAS __attribute__((address_space(3)))
typedef unsigned short bf16_t;
typedef short bf16x8 __attribute__((ext_vector_type(8)));
typedef float f32x4 __attribute__((ext_vector_type(4)));
typedef unsigned u32x4 __attribute__((ext_vector_type(4)));
constexpr int BM = 256, BK = 64, HALF = 128, HTB = HALF * BK * 2  , STAGE_BYTES = 8 * HTB, NXCD = 8, WGM = 8;

__host__ __device__ __forceinline__ int lds_byte(int r, int c) { const int st = (r >> 4) * 2 + (c >> 5), rr = r & 15, cc = c & 31, ob = rr * 64 + cc * 2; return st * 1024 + (ob ^ (((ob >> 9) & 1) << 5)); }
__host__ __device__ __forceinline__ void stage_rc(int b, int& R, int& C) { const int st = b / 1024, sb = b % 1024, swz = sb ^ (((sb >> 9) & 1) << 5); R = (st >> 1) * 16 + swz / 64; C = (st & 1) * 32 + (swz % 64) / 2; }
__host__ __device__ __forceinline__ int perm32(int rho) { const int n = rho >> 4, i = rho & 15; return 8 * (i >> 2) + 4 * n + (i & 3); }

struct Unit { int pm, pn, slot; };
struct Gemm { const bf16_t* A; const bf16_t* Bt; int M, N, K; };

struct StaticOrder {
    int nM, nN, nwg, G, c;
    __host__ __device__ void init(int M, int N, int G_, int c_) { nM = M / BM; nN = N / BM; nwg = nM * nN; G = G_; c = c_; }
    __host__ __device__ bool next(int i, Unit& u) const {
        const long L = (long)i * G + c; if (L >= nwg) return false;
        int wgid = (int)L; { const int q = nwg / NXCD, r = nwg % NXCD, xcd = wgid % NXCD, off = wgid / NXCD; wgid = (xcd < r ? xcd * (q + 1) : r * (q + 1) + (xcd - r) * q) + off; }
        const int nig = WGM * nN, gid = wgid / nig, fm = gid * WGM, gsz = (nM - fm) < WGM ? (nM - fm) : WGM;
        u.pm = fm + ((wgid % nig) % gsz); u.pn = (wgid % nig) / gsz; u.slot = i; return true;
    }
    __device__ __forceinline__ void a_ready(const Unit&) const {}
    __device__ __forceinline__ void done(const Unit&) const {}
};

__device__ __forceinline__ unsigned cvt_pk_bf16(float lo, float hi) { unsigned r; asm volatile("v_cvt_pk_bf16_f32 %0, %1, %2" : "=v"(r) : "v"(lo), "v"(hi)); return r; }
constexpr int SEQ = 16384, DM = 1024;
constexpr float RMS_EPS = 1e-6f;
__device__ __forceinline__ float row_rs(const float* ss, int row) {
    const f32x4* p = (const f32x4*)(ss + (size_t)row * 16); const f32x4 a = p[0], b = p[1], c = p[2], d = p[3];
    const float s = (((a[0] + a[1]) + (a[2] + a[3])) + ((b[0] + b[1]) + (b[2] + b[3]))) + (((c[0] + c[1]) + (c[2] + c[3])) + ((d[0] + d[1]) + (d[2] + d[3])));
    return 1.0f / sqrtf(s * (1.0f / 1024.0f) + RMS_EPS);
}
template <int MODE> struct EpiIn {
    static constexpr bool PERM = true, AFTER_DRAIN = false;
    bf16_t* O; const PG8_LAS float* rsl; const float* rope; int nsc; float scale0;
    float* ksum;
    __device__ __forceinline__ void operator()(const f32x4 (&acc)[2][2][4][2], const Unit& u, int wr, int wc, int fr, int fq) const {
        const int row0 = u.pm * BM + wr * 64 + fr;
        if (MODE == 2 && u.pn >= 4) {
            bf16_t* base = O + (size_t)SEQ * DM + (u.pn - 4) * 128 + wc * 32 + 8 * fq;
#pragma unroll
            for (int ai = 0; ai < 2; ++ai)
#pragma unroll
                for (int m = 0; m < 4; ++m) { const int row = row0 + ai * HALF + m * 16; const float rs = rsl[u.slot * 256 + (row & 255)], r2 = rs * rs;
                    const f32x4 v0 = acc[ai][0][m][0] * acc[ai][1][m][0] * r2, v1 = acc[ai][0][m][1] * acc[ai][1][m][1] * r2;
                    u32x4 w; w.x = cvt_pk_bf16(v0[0], v0[1]); w.y = cvt_pk_bf16(v0[2], v0[3]); w.z = cvt_pk_bf16(v1[0], v1[1]); w.w = cvt_pk_bf16(v1[2], v1[3]);
                    *(u32x4*)(base + (size_t)row * DM) = w; }
            return;
        }
        const int t = u.pn >> 2; bf16_t* base = O + (size_t)t * SEQ * DM + (u.pn & 3) * BM + wc * 32 + 8 * fq;
        const float sc = (u.pn < nsc) ? scale0 : 1.0f;
        const bool rot = (MODE == 1) && (t < 2) && ((wc & 1) == 0);
        f32x4 cs[2][2] = {{{0.f, 0.f, 0.f, 0.f}, {0.f, 0.f, 0.f, 0.f}}, {{0.f, 0.f, 0.f, 0.f}, {0.f, 0.f, 0.f, 0.f}}};
#pragma unroll
        for (int ai = 0; ai < 2; ++ai)
#pragma unroll
            for (int m = 0; m < 4; ++m) { const int row = row0 + ai * HALF + m * 16; const float rs = rsl[u.slot * 256 + (row & 255)] * sc;
                f32x4 c0 = {1.f, 1.f, 1.f, 1.f}, c1 = c0, s0 = {0.f, 0.f, 0.f, 0.f}, s1 = s0;
                if (MODE == 1) { if (rot) { const f32x4* rp = (const f32x4*)(rope + (size_t)row * 16); c0 = rp[0]; c1 = rp[1]; s0 = rp[2]; s1 = rp[3]; if (fq == 0) { s0 = -s0; s1 = -s1; } } }
#pragma unroll
                for (int bj = 0; bj < 2; ++bj) { f32x4 v0 = acc[ai][bj][m][0] * rs, v1 = acc[ai][bj][m][1] * rs;
                    if (MODE == 1) { if (rot) {
                        f32x4 p0, p1;
#pragma unroll
                        for (int e = 0; e < 4; ++e) { p0[e] = __shfl_xor(v0[e], 16); p1[e] = __shfl_xor(v1[e], 16); }
                        if (fq < 2) { v0 = v0 * c0 + p0 * s0; v1 = v1 * c1 + p1 * s1; } } }
                    if (MODE == 1) { cs[bj][0] += v0; cs[bj][1] += v1; }
                    u32x4 w; w.x = cvt_pk_bf16(v0[0], v0[1]); w.y = cvt_pk_bf16(v0[2], v0[3]); w.z = cvt_pk_bf16(v1[0], v1[1]); w.w = cvt_pk_bf16(v1[2], v1[3]);
                    *(u32x4*)(base + (size_t)row * DM + bj * HALF) = w; } }
        if (MODE == 1) { if (t == 1) {
#pragma unroll
            for (int bj = 0; bj < 2; ++bj)
#pragma unroll
                for (int n = 0; n < 2; ++n)
#pragma unroll
                    for (int e = 0; e < 4; ++e) { float x = cs[bj][n][e]; x += __shfl_xor(x, 1); x += __shfl_xor(x, 2); x += __shfl_xor(x, 4); x += __shfl_xor(x, 8);
                        if (fr == 0) { const int c = (u.pn & 3) * BM + bj * HALF + wc * 32 + 8 * fq + 4 * n + e; atomicAdd(ksum + ((size_t)(c >> 6) * 64 + u.pm) * 64 + (c & 63), x); } } } }
    }
};
template <bool RES_F32> struct EpiRes {
    static constexpr bool PERM = true, AFTER_DRAIN = false;
    const float* res; bf16_t* hb; float* ss;
    __device__ __forceinline__ void operator()(const f32x4 (&acc)[2][2][4][2], const Unit& u, int wr, int wc, int fr, int fq) const {
        const int row0 = u.pm * BM + wr * 64 + fr, col0 = u.pn * BM + wc * 32 + 8 * fq;
#pragma unroll
        for (int ai = 0; ai < 2; ++ai)
#pragma unroll
            for (int m = 0; m < 4; ++m) { const int row = row0 + ai * HALF + m * 16; const size_t off = (size_t)row * DM + col0; float q = 0.f;
#pragma unroll
                for (int bj = 0; bj < 2; ++bj) { f32x4 r0, r1;
                    if (RES_F32) { r0 = *(const f32x4*)(res + off + bj * HALF); r1 = *(const f32x4*)(res + off + bj * HALF + 4); }
                    else { const u32x4 rw = *(const u32x4*)(hb + off + bj * HALF);
                        r0 = (f32x4){__builtin_bit_cast(float, rw.x << 16), __builtin_bit_cast(float, rw.x & 0xffff0000u), __builtin_bit_cast(float, rw.y << 16), __builtin_bit_cast(float, rw.y & 0xffff0000u)};
                        r1 = (f32x4){__builtin_bit_cast(float, rw.z << 16), __builtin_bit_cast(float, rw.z & 0xffff0000u), __builtin_bit_cast(float, rw.w << 16), __builtin_bit_cast(float, rw.w & 0xffff0000u)}; }
                    const f32x4 h0 = r0 + acc[ai][bj][m][0], h1 = r1 + acc[ai][bj][m][1];
                    u32x4 w; w.x = cvt_pk_bf16(h0[0], h0[1]); w.y = cvt_pk_bf16(h0[2], h0[3]); w.z = cvt_pk_bf16(h1[0], h1[1]); w.w = cvt_pk_bf16(h1[2], h1[3]);
                    *(u32x4*)(hb + off + bj * HALF) = w;
                    q += ((h0[0] * h0[0] + h0[1] * h0[1]) + (h0[2] * h0[2] + h0[3] * h0[3])) + ((h1[0] * h1[0] + h1[1] * h1[1]) + (h1[2] * h1[2] + h1[3] * h1[3])); }
                q += __shfl_xor(q, 16); q += __shfl_xor(q, 32);
                if (fq == 0) ss[(size_t)row * 16 + u.pn * 4 + wc] = q; }
    }
};
struct EpiGlu {
    static constexpr bool PERM = true, AFTER_DRAIN = false;
    bf16_t* Hd; int ldh; const PG8_LAS float* rsl;
    __device__ __forceinline__ void operator()(const f32x4 (&acc)[2][2][4][2], const Unit& u, int wr, int wc, int fr, int fq) const {
        const int row0 = u.pm * BM + wr * 64 + fr; bf16_t* base = Hd + u.pn * 128 + wc * 32 + 8 * fq;
#pragma unroll
        for (int ai = 0; ai < 2; ++ai)
#pragma unroll
            for (int m = 0; m < 4; ++m) { const int row = row0 + ai * HALF + m * 16; const float rs = rsl[u.slot * 256 + (row & 255)]; float o[8];
#pragma unroll
                for (int n = 0; n < 2; ++n)
#pragma unroll
                    for (int e = 0; e < 4; ++e) { const float g = acc[ai][0][m][n][e] * rs, up = acc[ai][1][m][n][e] * rs;
                        o[n * 4 + e] = g * __builtin_amdgcn_rcpf(1.0f + __builtin_amdgcn_exp2f(g * -1.4426950408889634f)) * up; }
                u32x4 w; w.x = cvt_pk_bf16(o[0], o[1]); w.y = cvt_pk_bf16(o[2], o[3]); w.z = cvt_pk_bf16(o[4], o[5]); w.w = cvt_pk_bf16(o[6], o[7]);
                *(u32x4*)(base + (size_t)row * ldh) = w; }
    }
};

template <class Epi, class Sched, bool ALIGN_EPI = false, bool SP2 = false>
__device__ __forceinline__ void gemm_phase(PG8_LAS unsigned char* lds, const Gemm g, const Sched& S, const Epi& E) {
    const int tid = threadIdx.x, wid = __builtin_amdgcn_readfirstlane(tid >> 6), lane = tid & 63, wr = wid >> 2, wc = wid & 3, fr = lane & 15, fq = lane >> 4;
    const int K = g.K, nt = K / BK;
    unsigned voffA[2], voffB[2];
#pragma unroll
    for (int i = 0; i < 2; ++i) { int R, C; stage_rc(tid * 16 + i * 8192, R, C); const int Rb = Epi::PERM ? ((R & ~31) + perm32(R & 31)) : R;
        voffA[i] = (unsigned)(R * K + C) * 2u; voffB[i] = (unsigned)(Rb * K + C) * 2u; }
    const size_t kstep = (size_t)(BK * 2);
    const size_t hstep = (size_t)HALF * K * 2;
    const size_t tstep = 2 * hstep;
    const unsigned ldsw = (unsigned)wid * 1024u;
    const int aoff = lds_byte(wr * 64 + fr, fq * 8), boff = lds_byte(wc * 32 + fr, fq * 8);
#define PG8_SA(b, h) (((b) * 2 + (h)) * HTB)
#define PG8_SB(b, h) ((4 + (b) * 2 + (h)) * HTB)
#define PG8_STAGE(bufoff, gbase, voff) do { _Pragma("unroll") for (int _i = 0; _i < 2; ++_i) \
        __builtin_amdgcn_global_load_lds((const unsigned*)((const char*)(gbase) + (voff)[_i]), (PG8_LAS unsigned*)(lds + (bufoff) + ldsw + _i * 8192), 16, 0, 0); } while (0)
#define PG8_LDA(dst, b, h) do { _Pragma("unroll") for (int m = 0; m < 4; ++m) _Pragma("unroll") for (int k = 0; k < 2; ++k) dst[m][k] = *(const PG8_LAS bf16x8*)(lds + PG8_SA(b, h) + aoff + m * 2048 + k * 1024); } while (0)
#define PG8_LDB(dst, b, h) do { _Pragma("unroll") for (int n = 0; n < 2; ++n) _Pragma("unroll") for (int k = 0; k < 2; ++k) dst[n][k] = *(const PG8_LAS bf16x8*)(lds + PG8_SB(b, h) + boff + n * 2048 + k * 1024); } while (0)
#define PG8_MMA(ai, bj, At, Bt) do { __builtin_amdgcn_s_setprio(1); _Pragma("unroll") for (int m = 0; m < 4; ++m) _Pragma("unroll") for (int n = 0; n < 2; ++n) _Pragma("unroll") for (int k = 0; k < 2; ++k) \
        acc[ai][bj][m][n] = __builtin_amdgcn_mfma_f32_16x16x32_bf16(Bt[n][k], At[m][k], acc[ai][bj][m][n], 0, 0, 0); __builtin_amdgcn_s_setprio(0); } while (0)
#define PG8_WAIT_V(n) asm volatile("s_waitcnt vmcnt(" #n ")" ::: "memory")
#define PG8_WAIT_L(n) asm volatile("s_waitcnt lgkmcnt(" #n ")" ::: "memory")
#define PG8_BAR __builtin_amdgcn_s_barrier()
#define PG8_SCHED __builtin_amdgcn_sched_barrier(0)
    Unit cur, nxt; int ui = 0;
    if (!S.next(0, cur)) return;
    f32x4 acc[2][2][4][2];
#pragma unroll
    for (int a = 0; a < 2; ++a)
#pragma unroll
        for (int b = 0; b < 2; ++b)
#pragma unroll
            for (int m = 0; m < 4; ++m)
#pragma unroll
                for (int n = 0; n < 2; ++n) acc[a][b][m][n] = (f32x4){0.f, 0.f, 0.f, 0.f};
    bf16x8 At[4][2], B0[2][2], B1[2][2];
    const char* cA = (const char*)g.A + (size_t)cur.pm * tstep; const char* cB = (const char*)g.Bt + (size_t)cur.pn * tstep;
    S.a_ready(cur);
    if constexpr (SP2) {
        PG8_STAGE(PG8_SB(0, 0), cB, voffB); PG8_STAGE(PG8_SB(0, 1), cB + hstep, voffB); PG8_STAGE(PG8_SA(0, 0), cA, voffA); PG8_STAGE(PG8_SA(0, 1), cA + hstep, voffA);
        if (wr == 1) PG8_BAR;
        PG8_WAIT_V(2); PG8_BAR;
        PG8_STAGE(PG8_SB(1, 0), cB + kstep, voffB); PG8_STAGE(PG8_SA(1, 0), cA + kstep, voffA); PG8_STAGE(PG8_SB(1, 1), cB + hstep + kstep, voffB);
        PG8_WAIT_V(6); PG8_BAR;
    } else {
        PG8_STAGE(PG8_SB(0, 0), cB, voffB); PG8_STAGE(PG8_SA(0, 0), cA, voffA); PG8_STAGE(PG8_SB(0, 1), cB + hstep, voffB); PG8_STAGE(PG8_SA(0, 1), cA + hstep, voffA);
        if (wr == 1) PG8_BAR;
        PG8_WAIT_V(4); PG8_BAR;
        PG8_STAGE(PG8_SB(1, 0), cB + kstep, voffB); PG8_STAGE(PG8_SA(1, 0), cA + kstep, voffA); PG8_STAGE(PG8_SB(1, 1), cB + hstep + kstep, voffB);
        PG8_WAIT_V(6); PG8_BAR;
    }
    for (;;) {
        const bool has_next = S.next(ui + 1, nxt);
        const char* nA = has_next ? (const char*)g.A + (size_t)nxt.pm * tstep : cA; const char* nB = has_next ? (const char*)g.Bt + (size_t)nxt.pn * tstep : cB;
        for (int t = 0; t < nt; t += 2) {
            const bool last = (t == nt - 2);
            const char* a1 = cA + (size_t)(t + 1) * kstep;
            const char* a2 = last ? nA : cA + (size_t)(t + 2) * kstep; const char* b2 = last ? nB : cB + (size_t)(t + 2) * kstep;
            const char* a3 = a2 + kstep; const char* b3 = b2 + kstep;
            if (last && has_next) S.a_ready(nxt);
            if constexpr (SP2) {
            PG8_LDB(B0, 0, 0); PG8_LDB(B1, 0, 1); PG8_SCHED; PG8_LDA(At, 0, 0); PG8_STAGE(PG8_SA(1, 1), a1 + hstep, voffA);
            PG8_WAIT_V(8); PG8_WAIT_L(0); PG8_BAR; PG8_MMA(0, 0, At, B0); PG8_MMA(0, 1, At, B1); PG8_BAR; PG8_SCHED;
            PG8_LDA(At, 0, 1); PG8_STAGE(PG8_SB(0, 0), b2, voffB); PG8_STAGE(PG8_SB(0, 1), b2 + hstep, voffB); PG8_STAGE(PG8_SA(0, 0), a2, voffA);
            PG8_WAIT_V(8); PG8_WAIT_L(0); PG8_BAR; PG8_MMA(1, 0, At, B0); PG8_MMA(1, 1, At, B1); PG8_BAR; PG8_SCHED;
            PG8_LDB(B0, 1, 0); PG8_LDB(B1, 1, 1); PG8_SCHED; PG8_LDA(At, 1, 0); PG8_STAGE(PG8_SA(0, 1), a2 + hstep, voffA);
            PG8_WAIT_V(8); PG8_WAIT_L(0); PG8_BAR; PG8_MMA(0, 0, At, B0); PG8_MMA(0, 1, At, B1); PG8_BAR; PG8_SCHED;
            PG8_LDA(At, 1, 1); PG8_STAGE(PG8_SB(1, 0), b3, voffB); PG8_STAGE(PG8_SB(1, 1), b3 + hstep, voffB); PG8_STAGE(PG8_SA(1, 0), a3, voffA);
            PG8_WAIT_V(8); PG8_WAIT_L(0); PG8_BAR; PG8_MMA(1, 0, At, B0); PG8_MMA(1, 1, At, B1); PG8_BAR; PG8_SCHED;
            } else {
            PG8_LDB(B0, 0, 0); PG8_SCHED; PG8_LDA(At, 0, 0); PG8_STAGE(PG8_SA(1, 1), a1 + hstep, voffA);
            PG8_WAIT_L(8); PG8_BAR; PG8_WAIT_L(0); PG8_MMA(0, 0, At, B0); PG8_BAR; PG8_SCHED;
            PG8_LDB(B1, 0, 1); PG8_STAGE(PG8_SB(0, 0), b2, voffB);
            PG8_BAR; PG8_WAIT_L(0); PG8_MMA(0, 1, At, B1); PG8_BAR;
            PG8_LDA(At, 0, 1); PG8_STAGE(PG8_SA(0, 0), a2, voffA);
            PG8_BAR; PG8_WAIT_L(0); PG8_MMA(1, 0, At, B0); PG8_BAR; PG8_SCHED;
            PG8_STAGE(PG8_SB(0, 1), b2 + hstep, voffB);
            PG8_WAIT_V(6); PG8_BAR; PG8_MMA(1, 1, At, B1); PG8_BAR;
            PG8_LDB(B0, 1, 0); PG8_SCHED; PG8_LDA(At, 1, 0); PG8_STAGE(PG8_SA(0, 1), a2 + hstep, voffA);
            PG8_WAIT_L(8); PG8_BAR; PG8_WAIT_L(0); PG8_MMA(0, 0, At, B0); PG8_BAR; PG8_SCHED;
            PG8_LDB(B1, 1, 1); PG8_STAGE(PG8_SB(1, 0), b3, voffB);
            PG8_BAR; PG8_WAIT_L(0); PG8_MMA(0, 1, At, B1); PG8_BAR;
            PG8_LDA(At, 1, 1); PG8_STAGE(PG8_SA(1, 0), a3, voffA);
            PG8_BAR; PG8_WAIT_L(0); PG8_MMA(1, 0, At, B0); PG8_BAR; PG8_SCHED;
            PG8_STAGE(PG8_SB(1, 1), b3 + hstep, voffB);
            PG8_WAIT_V(6); PG8_BAR; PG8_MMA(1, 1, At, B1); PG8_BAR;
            }
        }
        if constexpr (ALIGN_EPI) { if (wr == 0) PG8_BAR; }
        if constexpr (!Epi::AFTER_DRAIN) { E(acc, cur, wr, wc, fr, fq); S.done(cur); }
        if (!has_next) break;
#pragma unroll
        for (int a = 0; a < 2; ++a)
#pragma unroll
            for (int b = 0; b < 2; ++b)
#pragma unroll
                for (int m = 0; m < 4; ++m)
#pragma unroll
                    for (int n = 0; n < 2; ++n) acc[a][b][m][n] = (f32x4){0.f, 0.f, 0.f, 0.f};
        cur = nxt; cA = nA; cB = nB; ++ui;
        if constexpr (ALIGN_EPI) { if (wr == 1) PG8_BAR; }
    }
    PG8_WAIT_V(0);
    if constexpr (!ALIGN_EPI) { if (wr == 0) PG8_BAR; }
    PG8_BAR;
    if constexpr (Epi::AFTER_DRAIN) { E.fused(acc, cur, wr, wc, fr, fq, lds, wid, lane); S.done(cur); }
#undef PG8_SA
#undef PG8_SB
#undef PG8_STAGE
#undef PG8_LDA
#undef PG8_LDB
#undef PG8_MMA
#undef PG8_WAIT_V
#undef PG8_WAIT_L
#undef PG8_BAR
#undef PG8_SCHED
}
}

constexpr int NWAVES = 8;
constexpr int S = 16384, D = 1024, FF = 2816, NHEAD = 16, DH = 64;
constexpr int ML_H = 4, ML_DK = 128, ML_DV = 256, ML_L = 128, ML_NC = S / ML_L, ML_IN = 3080;
constexpr int MB_BLK = 256, MB_NB = S / MB_BLK;
constexpr float EPS = 1e-6f;
constexpr float C2 = 0.125f * 1.4426950408889634f;
#ifndef MK_PER_PHASE
#define MK_PER_PHASE 0
#endif
constexpr int NPHASE = 26;
#ifndef PROBE_MASK
#define PROBE_MASK 0u
#endif
#define PROBE_MULT 4
#define PROBE_BLOCK 0
#define PROBE_PRE 0

constexpr size_t MiB = 1u << 20;
constexpr size_t WS_CTL = 0, CTL_ZERO_BYTES = 320 * 1024;
constexpr size_t WS_SS = 1 * MiB;
constexpr size_t WS_GATES = 2 * MiB;
constexpr size_t WS_ROPE = 3 * MiB;
constexpr size_t WS_GA = 4 * MiB;
constexpr size_t WS_MST = WS_GA + 8192;
constexpr size_t WS_ND = WS_GA + 16384;
constexpr size_t WS_NST = WS_ND + 262144;
constexpr size_t WS_KMEAN = 65536;
constexpr size_t WS_CNT = 32768;
constexpr size_t WS_WIN = 8 * MiB, WS_WOUT = 14 * MiB, WS_WGU = 16 * MiB, WS_WD = 27 * MiB;
constexpr size_t WS_T0 = 33 * MiB, WS_T1 = 65 * MiB, WS_T2 = 97 * MiB;
constexpr size_t WS_HB = 129 * MiB;
constexpr size_t WS_X = 161 * MiB;
constexpr size_t WS_CT = WS_X;
constexpr size_t WS_PO2 = WS_X, WS_LSE = WS_X + 32 * MiB, WS_LIST = WS_X + 36 * MiB;
constexpr size_t WS_WGU1 = WS_LIST + 17 * MiB, WS_WD1 = WS_WGU1 + 11 * MiB;
constexpr size_t WS_END = WS_WD1 + 6 * MiB;
static_assert(WS_END <= 256 * MiB, "workspace map");
constexpr int LIST_HEAD_CAP = 256 * 2016;
constexpr int CW_BAR = 1024;

constexpr int LDS_BYTES = 147456;
constexpr int MISC_OFF = LDS_BYTES - 256;
constexpr int CONV_SCR = 8704, AUX_OFF = 8 * CONV_SCR;
constexpr int RSL_OFF = 131072;
constexpr int SCAL_OFF = 139264;

#define GAS __attribute__((address_space(1)))
#define LAS __attribute__((address_space(3)))
typedef unsigned short bf16;
typedef unsigned v4u __attribute__((ext_vector_type(4)));
typedef unsigned v2u __attribute__((ext_vector_type(2)));
typedef float f32x4 __attribute__((ext_vector_type(4)));
typedef float f32x16 __attribute__((ext_vector_type(16)));
typedef short bf16x8 __attribute__((ext_vector_type(8)));
typedef short s16x4 __attribute__((ext_vector_type(4)));
typedef GAS unsigned gu32;
#define RLX_AGENT __ATOMIC_RELAXED, __HIP_MEMORY_SCOPE_AGENT
#define LDS_WAIT() asm volatile("s_waitcnt lgkmcnt(0)" ::: "memory")
#define VM_WAIT() asm volatile("s_waitcnt vmcnt(0)" ::: "memory")
__device__ __forceinline__ unsigned f2bf(float f) { unsigned u = __builtin_bit_cast(unsigned, f); return (u + 0x7fffu + ((u >> 16) & 1u)) >> 16; }
__device__ __forceinline__ unsigned pk2(float lo, float hi) { return pg8::cvt_pk_bf16(lo, hi); }
__device__ __forceinline__ float bf_lo(unsigned w) { return __builtin_bit_cast(float, w << 16); }
__device__ __forceinline__ float bf_hi(unsigned w) { return __builtin_bit_cast(float, w & 0xffff0000u); }
__device__ __forceinline__ float ex2(float x) { return __builtin_amdgcn_exp2f(x); }
__device__ __forceinline__ float lg2(float x) { return __builtin_amdgcn_logf(x); }
__device__ __forceinline__ int crow(int r, int hi) { return (r & 3) + 8 * (r >> 2) + 4 * hi; }
#define MFMA32(a, b, c) __builtin_amdgcn_mfma_f32_32x32x16_bf16((a), (b), (c), 0, 0, 0)
typedef short v4i16_t __attribute__((ext_vector_type(4)));
__device__ __forceinline__ s16x4 ldtr(LAS const unsigned char* p) { return __builtin_bit_cast(s16x4, __builtin_amdgcn_ds_read_tr16_b64_v4i16((LAS v4i16_t*)p)); }
__device__ __forceinline__ bf16x8 cat8(s16x4 a, s16x4 b) { return (bf16x8){a[0], a[1], a[2], a[3], b[0], b[1], b[2], b[3]}; }
__device__ __forceinline__ int tr_lane_off(int lane, int stride) { return ((lane & 15) >> 2) * stride + (((lane >> 4) & 1) * 16 + (lane & 3) * 4) * 2; }
__device__ __forceinline__ bf16x8 frag_tr_nat(LAS const unsigned char* tile, int stride, int k0, int n0, int lane, int troff) {
    LAS const unsigned char* p = tile + (k0 + 8 * (lane >> 5)) * stride + n0 * 2 + troff; return cat8(ldtr(p), ldtr(p + 4 * stride)); }
__device__ __forceinline__ bf16x8 frag_tr_acc(LAS const unsigned char* tile, int stride, int k0, int n0, int lane, int troff) {
    LAS const unsigned char* p = tile + (k0 + 4 * (lane >> 5)) * stride + n0 * 2 + troff; return cat8(ldtr(p), ldtr(p + 8 * stride)); }
__device__ __forceinline__ bf16x8 frag_row(LAS const unsigned char* tile, int stride, int r0, int c0, int lane) {
    return *(LAS const bf16x8*)(tile + (r0 + (lane & 31)) * stride + (c0 + 8 * (lane >> 5)) * 2); }
__device__ __forceinline__ bf16x8 pack_acc(const f32x16& p, int s) {
    v4u w; w.x = pk2(p[8 * s + 0], p[8 * s + 1]); w.y = pk2(p[8 * s + 2], p[8 * s + 3]); w.z = pk2(p[8 * s + 4], p[8 * s + 5]); w.w = pk2(p[8 * s + 6], p[8 * s + 7]); return __builtin_bit_cast(bf16x8, w); }
__device__ __forceinline__ void halves(float x, float& half0, float& half1) { const unsigned u = __builtin_bit_cast(unsigned, x); auto rr = __builtin_amdgcn_permlane32_swap(u, u, false, false);
    half0 = __builtin_bit_cast(float, (unsigned)rr[0]); half1 = __builtin_bit_cast(float, (unsigned)rr[1]); }
__device__ __forceinline__ float hsum(float x) { float a, b; halves(x, a, b); return a + b; }
__device__ __forceinline__ float hmax(float x) { float a, b; halves(x, a, b); return fmaxf(a, b); }
__device__ __forceinline__ float max16(const f32x16& p) {
    const float a = fmaxf(fmaxf(p[0], p[1]), fmaxf(p[2], p[3])), b = fmaxf(fmaxf(p[4], p[5]), fmaxf(p[6], p[7])), c = fmaxf(fmaxf(p[8], p[9]), fmaxf(p[10], p[11])), d = fmaxf(fmaxf(p[12], p[13]), fmaxf(p[14], p[15]));
    return fmaxf(fmaxf(a, b), fmaxf(c, d)); }
__device__ __forceinline__ float sum16(const f32x16& p) { return (((p[0] + p[1]) + (p[2] + p[3])) + ((p[4] + p[5]) + (p[6] + p[7]))) + (((p[8] + p[9]) + (p[10] + p[11])) + ((p[12] + p[13]) + (p[14] + p[15]))); }
__device__ __forceinline__ float wave_sum(float v) {
#pragma unroll
    for (int o = 1; o < 64; o <<= 1) v += __shfl_xor(v, o);
    return v;
}
__device__ __forceinline__ float wave_max(float v) {
#pragma unroll
    for (int o = 1; o < 64; o <<= 1) v = fmaxf(v, __shfl_xor(v, o));
    return v;
}
#define XB_TMO      128
#define XB_XCNT(j)  (256  + 64 * (j))
#define XB_XSUB(j)  (1280 + 64 * (j))
#define XB_XGEN(j)  (2304 + 64 * (j))
#define XB_TOP      3328
#define XB_TOPGEN   3392
#define XCD_BAR_WORDS 3456
#define XB_SPIN_CAP (1u << 18)

__device__ __forceinline__ unsigned xb_ld(unsigned* p)              { return __hip_atomic_load(p, __ATOMIC_RELAXED, __HIP_MEMORY_SCOPE_AGENT); }
__device__ __forceinline__ unsigned xb_add(unsigned* p, unsigned v) { return __hip_atomic_fetch_add(p, v, __ATOMIC_RELAXED, __HIP_MEMORY_SCOPE_AGENT); }
__device__ __forceinline__ unsigned xb_xcc_id() { return (unsigned)__builtin_amdgcn_s_getreg((3 << 11) | 20) & 0xFu; }
#define XB_SPIN(cond, bar) do { unsigned _sp = 0; while (cond) { __builtin_amdgcn_s_sleep(1); \
    if ((++_sp & 255u) == 0u) { if (xb_ld(&(bar)[XB_TMO])) break; if (_sp > XB_SPIN_CAP) { atomicAdd(&(bar)[XB_TMO], 1u); break; } } } } while (0)

struct XcdBarrier {
    unsigned* bar; unsigned x;
    volatile LAS unsigned* st;
};

__device__ __forceinline__ XcdBarrier xcd_barrier_post(unsigned* bar, volatile LAS unsigned* st) {
    XcdBarrier b; b.bar = bar; b.x = xb_xcc_id(); b.st = st;
    if (threadIdx.x == 0) (void)xb_add(&bar[XB_XCNT(b.x)], 1u);
    return b;
}
__device__ __forceinline__ void xcd_barrier_complete(unsigned* bar, unsigned x, unsigned& nloc, unsigned& nx) {
    const unsigned G = gridDim.x * gridDim.y * gridDim.z;
    unsigned sum, cnt, mine, sp = 0u;
    for (;;) {
        sum = 0u; cnt = 0u; mine = 0u;
#pragma unroll
        for (unsigned j = 0; j < 16; ++j) { const unsigned c = xb_ld(&bar[XB_XCNT(j)]); sum += c; cnt += (c > 0u) ? 1u : 0u; mine = (j == x) ? c : mine; }
        if (sum == G) break;
        __builtin_amdgcn_s_sleep(1);
        if ((++sp & 255u) == 0u) { if (xb_ld(&bar[XB_TMO])) break; if (sp > XB_SPIN_CAP) { atomicAdd(&bar[XB_TMO], 1u); break; } }
    }
    nloc = mine > 0u ? mine : 1u; nx = cnt > 0u ? cnt : 1u;
}

__device__ __forceinline__ void xcd_barrier(const XcdBarrier& b) {
    asm volatile("s_waitcnt vmcnt(0)" ::: "memory");
    __syncthreads();
    if (threadIdx.x == 0) {
        unsigned* bar = b.bar;
        __builtin_amdgcn_s_waitcnt(0);
        unsigned nloc = b.st[0], nx = b.st[1];
        if (nloc == 0u) { xcd_barrier_complete(bar, b.x, nloc, nx); b.st[0] = nloc; b.st[1] = nx; }
        const unsigned old = xb_add(&bar[XB_XSUB(b.x)], 1u);
        const unsigned gen = old / nloc;
        if (old + 1u == (gen + 1u) * nloc) {
            __builtin_amdgcn_fence(__ATOMIC_RELEASE, "agent");
            asm volatile("s_waitcnt vmcnt(0)" ::: "memory");
            const unsigned og = xb_add(&bar[XB_TOP], 1u);
            const unsigned tg = og / nx;
            if (og + 1u == (tg + 1u) * nx) xb_add(&bar[XB_TOPGEN], 1u);
            else XB_SPIN(xb_ld(&bar[XB_TOPGEN]) == tg, bar);
            __builtin_amdgcn_fence(__ATOMIC_ACQUIRE, "agent");
            xb_add(&bar[XB_XGEN(b.x)], 1u);
            asm volatile("s_waitcnt vmcnt(0)" ::: "memory");
        } else {
            XB_SPIN(xb_ld(&bar[XB_XGEN(b.x)]) == gen, bar);
            __builtin_amdgcn_fence(__ATOMIC_ACQUIRE, "agent");
            asm volatile("s_waitcnt vmcnt(0)" ::: "memory");
        }
    }
    __syncthreads();
}

struct Frame {
    LAS unsigned char* lds;
    volatile LAS unsigned* MISC;
    gu32* ctl;
    int tid, lane, wave;
    int G;
    unsigned char* ws;
    const float* in[18]; float* out;
};
#define WSP(T, off) ((T*)(F.ws + (off)))

struct CvM { const float* W; const float* gain; bf16* WT; int ldw, K, nblk, nitems, kind, half, base; };
__device__ __forceinline__ CvM cvm(const float* W, int ldw, int K, int N, const float* gain, bf16* WT, int kind, int half, int base) { CvM m; m.W = W; m.gain = gain; m.WT = WT; m.ldw = ldw; m.K = K; m.nblk = N / 32; m.nitems = (K / 64) * (N / 32); m.kind = kind; m.half = half; m.base = base; return m; }
template <int NM> __device__ __forceinline__ CvM cv_pick(const CvM (&ms)[NM], int it, int& li) {
    CvM m = ms[0]; li = it; int acc = 0;
#pragma unroll
    for (int i = 1; i < NM; ++i) { acc += ms[i - 1].nitems; const bool t = it >= acc;
        m.W = t ? ms[i].W : m.W; m.gain = t ? ms[i].gain : m.gain; m.WT = t ? ms[i].WT : m.WT; m.ldw = t ? ms[i].ldw : m.ldw; m.K = t ? ms[i].K : m.K; m.nblk = t ? ms[i].nblk : m.nblk;
        m.nitems = t ? ms[i].nitems : m.nitems; m.kind = t ? ms[i].kind : m.kind; m.half = t ? ms[i].half : m.half; m.base = t ? ms[i].base : m.base; li = t ? it - acc : li; }
    return m;
}
__device__ __forceinline__ void cv_load(const CvM& m, int li, int lane, float (&v)[32]) {
    const int kb = li / m.nblk, nb = li - kb * m.nblk; const float* p = m.W + (size_t)(64 * kb + (lane >> 5)) * m.ldw + 32 * nb + (lane & 31);
#pragma unroll
    for (int i = 0; i < 32; ++i) v[i] = p[(size_t)(2 * i) * m.ldw];
}
__device__ __forceinline__ void cv_finish(const CvM& m, int li, int lane, const float (&v)[32], LAS float* scr) {
    const int kb = li / m.nblk, nb = li - kb * m.nblk, k0 = 64 * kb, n0 = 32 * nb;
    const int orow0 = (m.kind == 0) ? m.base + n0 : m.base + (n0 >> 7) * 256 + m.half * 128 + (n0 & 127);
#pragma unroll
    for (int i = 0; i < 32; ++i) scr[(2 * i + (lane >> 5)) * 33 + (lane & 31)] = v[i];
    const int c = lane & 7;
    f32x4 g0 = {1.f, 1.f, 1.f, 1.f}, g1 = g0; if (m.gain) { g0 = *(const f32x4*)(m.gain + k0 + 8 * c); g1 = *(const f32x4*)(m.gain + k0 + 8 * c + 4); }
    LDS_WAIT(); asm volatile("" ::: "memory");
#pragma unroll
    for (int j = 0; j < 4; ++j) { const int n = (lane >> 3) + 8 * j; const LAS float* s = scr + (8 * c) * 33 + n;
        v4u o; o.x = pk2(s[0 * 33] * g0[0], s[1 * 33] * g0[1]); o.y = pk2(s[2 * 33] * g0[2], s[3 * 33] * g0[3]); o.z = pk2(s[4 * 33] * g1[0], s[5 * 33] * g1[1]); o.w = pk2(s[6 * 33] * g1[2], s[7 * 33] * g1[3]);
        *(GAS v4u*)(m.WT + (size_t)(orow0 + n) * m.K + k0 + 8 * c) = o; }
    LDS_WAIT(); asm volatile("" ::: "memory");
}
template <int NM> __device__ __forceinline__ void convert_stream(Frame& F, const CvM (&ms)[NM], int b0) {
    LAS float* scr = (LAS float*)(F.lds + F.wave * CONV_SCR); const int gw = ((int)blockIdx.x - b0) * NWAVES + F.wave, NGW = (F.G - b0) * NWAVES, lane = F.lane;
    if ((int)blockIdx.x < b0) return;
    int total = 0;
#pragma unroll
    for (int i = 0; i < NM; ++i) total += ms[i].nitems;
    int it = gw; if (it >= total) return;
    float va[32], vb[32]; int li; CvM m = cv_pick(ms, it, li); cv_load(m, li, lane, va);
    for (;;) {
        const int itn = it + NGW; int lin = 0; CvM mn = m; const bool more = itn < total; if (more) { mn = cv_pick(ms, itn, lin); cv_load(mn, lin, lane, vb); }
        cv_finish(m, li, lane, va, scr); if (!more) break;
        const int itn2 = itn + NGW; int lin2 = 0; CvM mn2 = mn; const bool more2 = itn2 < total; if (more2) { mn2 = cv_pick(ms, itn2, lin2); cv_load(mn2, lin2, lane, va); }
        cv_finish(mn, lin, lane, vb, scr); if (!more2) break;
        it = itn2; m = mn2; li = lin2;
    }
}
__device__ __forceinline__ void convert_layer(Frame& F, int layer, int b0) {
    const float* g0 = F.in[2] + (size_t)layer * 2 * D; const float* g1 = g0 + D; bf16* WIN = WSP(bf16, WS_WIN);
    const float* wo = (layer == 0) ? F.in[6] : (layer == 1) ? F.in[8] : (layer == 2) ? F.in[11] : F.in[13];
    bf16* WGUb = (layer & 1) ? WSP(bf16, WS_WGU1) : WSP(bf16, WS_WGU); bf16* WDb = (layer & 1) ? WSP(bf16, WS_WD1) : WSP(bf16, WS_WD);
    const CvM m_out = cvm(wo, D, D, D, nullptr, WSP(bf16, WS_WOUT), 0, 0, 0), m_g = cvm(F.in[14] + (size_t)layer * D * FF, FF, D, FF, g1, WGUb, 1, 0, 0),
              m_u = cvm(F.in[15] + (size_t)layer * D * FF, FF, D, FF, g1, WGUb, 1, 1, 0), m_d = cvm(F.in[16] + (size_t)layer * FF * D, D, FF, D, nullptr, WDb, 0, 0, 0);
    if (layer == 2) { const CvM ms[7] = {cvm(F.in[9], 3 * D, D, D, g0, WIN, 0, 0, 0), cvm(F.in[9] + D, 3 * D, D, D, g0, WIN, 1, 0, D), cvm(F.in[9] + 2 * D, 3 * D, D, D, g0, WIN, 1, 1, D), m_out, m_g, m_u, m_d};
        convert_stream(F, ms, b0); }
    else { const CvM ms[5] = {cvm(layer == 0 ? F.in[3] : layer == 1 ? F.in[7] : F.in[12], layer == 0 ? ML_IN : 3 * D, D, 3 * D, g0, WIN, 0, 0, 0), m_out, m_g, m_u, m_d}; convert_stream(F, ms, b0); }
}

__device__ __forceinline__ void prologue_rows(Frame& F) {
    const float* x = F.in[0]; const float* g0 = F.in[2]; const float* win = F.in[3]; const float* bg = F.in[4];
    bf16* hb = WSP(bf16, WS_HB); float* ss = WSP(float, WS_SS); float* gates = WSP(float, WS_GATES);
    const int gw = blockIdx.x * NWAVES + F.wave, NGW = F.G * NWAVES, lane = F.lane;
    float gwt[4][4][8];
#pragma unroll
    for (int j = 0; j < 4; ++j) { const int d0 = 4 * (lane + 64 * j); const f32x4 gg = *(const f32x4*)(g0 + d0);
#pragma unroll
        for (int e = 0; e < 4; ++e) { const f32x4* wp = (const f32x4*)(win + (size_t)(d0 + e) * ML_IN + 3072); const f32x4 w0 = wp[0], w1 = wp[1];
#pragma unroll
            for (int k = 0; k < 4; ++k) { gwt[j][e][k] = w0[k] * gg[e]; gwt[j][e][4 + k] = w1[k] * gg[e]; } } }
    for (int row0 = gw; row0 < S; row0 += 2 * NGW) {
        const bool two = (row0 + NGW) < S; f32x4 vv[2][4];
#pragma unroll
        for (int rr = 0; rr < 2; ++rr) { const f32x4* xr = (const f32x4*)(x + (size_t)(rr && two ? row0 + NGW : row0) * D) + lane;
#pragma unroll
            for (int j = 0; j < 4; ++j) vv[rr][j] = xr[64 * j]; }
#pragma unroll
        for (int rr = 0; rr < 2; ++rr) { if (rr && !two) break; const int row = row0 + rr * NGW; float s = 0.f;
#pragma unroll
            for (int j = 0; j < 4; ++j) { const f32x4 v = vv[rr][j]; s += (v[0] * v[0] + v[1] * v[1]) + (v[2] * v[2] + v[3] * v[3]); }
            s = wave_sum(s);
            if (lane < 16) ss[(size_t)row * 16 + lane] = (lane == 0) ? s : 0.f;
            unsigned long long* o8 = (unsigned long long*)(hb + (size_t)row * D) + lane;
#pragma unroll
            for (int j = 0; j < 4; ++j) o8[64 * j] = (unsigned long long)pk2(vv[rr][j][0], vv[rr][j][1]) | ((unsigned long long)pk2(vv[rr][j][2], vv[rr][j][3]) << 32);
            float a[8];
#pragma unroll
            for (int k = 0; k < 8; ++k) a[k] = 0.f;
#pragma unroll
            for (int j = 0; j < 4; ++j)
#pragma unroll
                for (int e = 0; e < 4; ++e)
#pragma unroll
                    for (int k = 0; k < 8; ++k) a[k] += vv[rr][j][e] * gwt[j][e][k];
            float b4[4], b2[2], b1;
#pragma unroll
            for (int k = 0; k < 4; ++k) { const float keep = (lane & 4) ? a[k + 4] : a[k], give = (lane & 4) ? a[k] : a[k + 4]; b4[k] = keep + __shfl_xor(give, 4); }
#pragma unroll
            for (int k = 0; k < 2; ++k) { const float keep = (lane & 2) ? b4[k + 2] : b4[k], give = (lane & 2) ? b4[k] : b4[k + 2]; b2[k] = keep + __shfl_xor(give, 2); }
            { const float keep = (lane & 1) ? b2[1] : b2[0], give = (lane & 1) ? b2[0] : b2[1]; b1 = keep + __shfl_xor(give, 1); }
            b1 += __shfl_xor(b1, 8); b1 += __shfl_xor(b1, 16); b1 += __shfl_xor(b1, 32);
            const float r = 1.0f / sqrtf(s * (1.0f / D) + EPS);
            if (lane < 8) gates[(size_t)row * 8 + lane] = b1 * r + bg[lane]; }
    }
    const int* pos = (const int*)F.in[1]; float* rope = WSP(float, WS_ROPE);
    const double inv_rev[8] = {0.15915494309189535, 0.03086376340470123, 0.005985185712713705, 0.001160663641240061, 0.00022507907903927653, 4.364795279280289e-05, 8.464330808241401e-06, 1.6414262627950345e-06};
    for (int idx = blockIdx.x * 512 + F.tid; idx < S * 8; idx += F.G * 512) { const int t = idx >> 3, i = idx & 7;
        double ir = inv_rev[0];
#pragma unroll
        for (int k = 1; k < 8; ++k) ir = (i == k) ? inv_rev[k] : ir;
        const double rev = (double)pos[t] * ir; const float fr = (float)(rev - __builtin_rint(rev));
        rope[(size_t)t * 16 + i] = __builtin_amdgcn_cosf(fr); rope[(size_t)t * 16 + 8 + i] = __builtin_amdgcn_sinf(fr); }
}

__device__ __forceinline__ void ml_chunk_scalars(const float* gates, int c, int hh, int lane, float& b0, float& b1, float& cs0, float& cs1, float& G, float& csmax) {
    const int t0 = c * ML_L + 2 * lane;
    const float f0 = gates[(size_t)t0 * 8 + 4 + hh], f1 = gates[(size_t)(t0 + 1) * 8 + 4 + hh], i0 = gates[(size_t)t0 * 8 + hh], i1 = gates[(size_t)(t0 + 1) * 8 + hh];
    const float l0 = fminf(f0, 0.f) - __logf(1.0f + __expf(-fabsf(f0))), l1 = fminf(f1, 0.f) - __logf(1.0f + __expf(-fabsf(f1)));
    float inc = l0 + l1;
#pragma unroll
    for (int o = 1; o < 64; o <<= 1) { const float t = __shfl_up(inc, o); if (lane >= o) inc += t; }
    b1 = inc; b0 = inc - l1; cs0 = i0 - b0; cs1 = i1 - b1;
    G = __shfl(inc, 63); csmax = wave_max(fmaxf(cs0, cs1));
}
template <int COLS> __device__ __forceinline__ void ml_load_tile(const bf16* g, int gp, LAS unsigned char* tile, int ls, int tid) {
    const int row = tid >> 2, seg = tid & 3; constexpr int PER = COLS / 4;
    const v4u* src = (const v4u*)(g + (size_t)row * gp + seg * PER); LAS v4u* dst = (LAS v4u*)(tile + row * ls + seg * PER * 2);
#pragma unroll
    for (int i = 0; i < PER / 8; ++i) dst[i] = src[i];
}
constexpr int ML_TS = 272;
__device__ __forceinline__ void mlstm_phase_a(Frame& F) {
    const bf16* T0 = WSP(bf16, WS_T0); const bf16* T1 = WSP(bf16, WS_T1); const float* gates = WSP(float, WS_GATES);
    float* Dt = F.out; float* nD = WSP(float, WS_ND); float* GA = WSP(float, WS_GA);
    LAS unsigned char* kw = F.lds; LAS unsigned char* vt = F.lds + 34816; constexpr int VS = 528;
    LAS float* wsc = (LAS float*)(F.lds + SCAL_OFF);
    const int tid = F.tid, lane = F.lane, w = F.wave, hi = lane >> 5, qn = lane & 31;
    for (int u = blockIdx.x; u < ML_NC * ML_H; u += F.G) { const int c = u >> 2, hh = u & 3;
        if (w == 0) { float b0, b1, cs0, cs1, G, cm; ml_chunk_scalars(gates, c, hh, lane, b0, b1, cs0, cs1, G, cm);
            wsc[2 * lane] = __expf(cs0 - cm); wsc[2 * lane + 1] = __expf(cs1 - cm);
            if (lane == 0) { GA[(size_t)u * 2] = G; GA[(size_t)u * 2 + 1] = G + cm; } }
        __syncthreads();
        {
            const int row = tid >> 2, seg = tid & 3; const float ws_ = wsc[row];
            const v4u* src = (const v4u*)(T0 + (size_t)(c * ML_L + row) * D + 512 + hh * ML_DK + seg * 32); LAS v4u* dst = (LAS v4u*)(kw + row * ML_TS + seg * 64);
#pragma unroll
            for (int i = 0; i < 4; ++i) { const v4u x = src[i]; v4u y;
                y.x = pk2(bf_lo(x.x) * ws_, bf_hi(x.x) * ws_); y.y = pk2(bf_lo(x.y) * ws_, bf_hi(x.y) * ws_); y.z = pk2(bf_lo(x.z) * ws_, bf_hi(x.z) * ws_); y.w = pk2(bf_lo(x.w) * ws_, bf_hi(x.w) * ws_); dst[i] = y; }
            ml_load_tile<256>(T1 + (size_t)(c * ML_L) * D + hh * ML_DV, D, vt, VS, tid);
        }
        __syncthreads();
        { const int tk = tr_lane_off(lane, ML_TS), tv = tr_lane_off(lane, VS);
          f32x16 acc[4];
#pragma unroll
          for (int i = 0; i < 4; ++i) acc[i] = (f32x16){};
#pragma unroll
          for (int ks = 0; ks < 8; ++ks) { const bf16x8 a = frag_tr_nat(vt, VS, 16 * ks, 32 * w, lane, tv);
#pragma unroll
              for (int dkt = 0; dkt < 4; ++dkt) { const bf16x8 b = frag_tr_nat(kw, ML_TS, 16 * ks, 32 * dkt, lane, tk); acc[dkt] = MFMA32(a, b, acc[dkt]); } }
          float* dst = Dt + (size_t)u * ML_DV * ML_DK;
#pragma unroll
          for (int dkt = 0; dkt < 4; ++dkt)
#pragma unroll
              for (int r = 0; r < 16; ++r) dst[(size_t)(32 * w + crow(r, hi)) * ML_DK + 32 * dkt + qn] = acc[dkt][r];
        }
        { float s = 0.f; const LAS bf16* col = (const LAS bf16*)kw + (tid & 127) + (tid >> 7) * 32 * (ML_TS / 2);
#pragma unroll 8
            for (int r = 0; r < 32; ++r) s += __builtin_bit_cast(float, (unsigned)col[r * (ML_TS / 2)] << 16);
            wsc[256 + tid] = s; }
        __syncthreads();
        if (tid < ML_DK) nD[(size_t)u * ML_DK + tid] = (wsc[256 + tid] + wsc[384 + tid]) + (wsc[512 + tid] + wsc[640 + tid]);
        __syncthreads();
    }
}
__device__ __forceinline__ void mlstm_phase_scan(Frame& F) {
    const float* GA = WSP(float, WS_GA); const float* Dt = F.out; const float* nD = WSP(float, WS_ND);
    bf16* Ct = WSP(bf16, WS_CT); float* nst = WSP(float, WS_NST); float* mst = WSP(float, WS_MST);
    LAS float* dec = (LAS float*)F.lds; LAS float* inj = dec + 512;
    if (F.wave < ML_H) { const int hh = F.wave, lane = F.lane;
        const float G0 = GA[(size_t)((2 * lane) * 4 + hh) * 2], A0 = GA[(size_t)((2 * lane) * 4 + hh) * 2 + 1], G1 = GA[(size_t)((2 * lane + 1) * 4 + hh) * 2], A1 = GA[(size_t)((2 * lane + 1) * 4 + hh) * 2 + 1];
        float inc = G0 + G1;
#pragma unroll
        for (int o = 1; o < 64; o <<= 1) { const float t = __shfl_up(inc, o); if (lane >= o) inc += t; }
        const float PG0 = inc - (G0 + G1), PG1 = PG0 + G0, x0 = A0 - PG1, x1 = A1 - inc;
        float pm = fmaxf(x0, x1);
#pragma unroll
        for (int o = 1; o < 64; o <<= 1) { const float t = __shfl_up(pm, o); if (lane >= o) pm = fmaxf(pm, t); }
        float pmx = __shfl_up(pm, 1); if (lane == 0) pmx = -3.0e38f;
        const float mx0 = fmaxf(0.f, pmx), mx1 = fmaxf(mx0, x0), mx2 = fmaxf(mx1, x1);
        const float m0 = PG0 + mx0, m1 = PG1 + mx1, m2 = inc + mx2;
        dec[hh * 128 + 2 * lane] = __expf(G0 + m0 - m1); inj[hh * 128 + 2 * lane] = __expf(A0 - m1);
        dec[hh * 128 + 2 * lane + 1] = __expf(G1 + m1 - m2); inj[hh * 128 + 2 * lane + 1] = __expf(A1 - m2);
        if (blockIdx.x == 0) { mst[(2 * lane) * 4 + hh] = m0; mst[(2 * lane + 1) * 4 + hh] = m1; } }
    __syncthreads();
    constexpr int NE = ML_H * ML_DV * ML_DK;
    for (int e = blockIdx.x * 512 + F.tid; e < NE; e += F.G * 512) { const int hh = e >> 15, rem = e & 32767; float C = 0.f;
        for (int c0 = 0; c0 < ML_NC; c0 += 16) { float dv[16];
#pragma unroll
            for (int i = 0; i < 16; ++i) dv[i] = Dt[(size_t)((c0 + i) * 4 + hh) * 32768 + rem];
#pragma unroll
            for (int i = 0; i < 16; ++i) { const size_t idx = (size_t)((c0 + i) * 4 + hh) * 32768 + rem; Ct[idx] = (bf16)f2bf(C); C = dec[hh * 128 + c0 + i] * C + inj[hh * 128 + c0 + i] * dv[i]; } } }
    for (int e = blockIdx.x * 512 + F.tid; e < ML_H * ML_DK; e += F.G * 512) { const int hh = e >> 7, dk = e & 127; float n = 0.f;
        for (int c0 = 0; c0 < ML_NC; c0 += 16) { float dv[16];
#pragma unroll
            for (int i = 0; i < 16; ++i) dv[i] = nD[(size_t)((c0 + i) * 4 + hh) * 128 + dk];
#pragma unroll
            for (int i = 0; i < 16; ++i) { nst[(size_t)((c0 + i) * 4 + hh) * 128 + dk] = n; n = dec[hh * 128 + c0 + i] * n + inj[hh * 128 + c0 + i] * dv[i]; } } }
    __syncthreads();
}
__device__ __forceinline__ void mlstm_phase_c(Frame& F) {
    const bf16* T0 = WSP(bf16, WS_T0); const bf16* T1 = WSP(bf16, WS_T1); bf16* T2 = WSP(bf16, WS_T2); const float* gates = WSP(float, WS_GATES);
    const bf16* Ct = WSP(bf16, WS_CT); const float* nst = WSP(float, WS_NST); const float* mst = WSP(float, WS_MST); const float* hgain = F.in[5];
    LAS unsigned char* qt = F.lds; LAS unsigned char* kt = F.lds + 34816; LAS unsigned char* vt = F.lds + 2 * 34816; LAS unsigned char* ct = F.lds + 3 * 34816;
    LAS float* sc = (LAS float*)(F.lds + SCAL_OFF);
    LAS float* sM = sc, * sCS = sc + 128, * sWI = sc + 256, * sEM = sc + 384, * sNV = sc + 512, * sQN = sc + 640, * sDS = sc + 768  , * sSQ = sc + 1024  , * sQP = sc + 1280  ;
    const int tid = F.tid, lane = F.lane, w = F.wave, hi = lane >> 5, qn = lane & 31, tb = w & 3, wh = w >> 2;
    const int trv = tr_lane_off(lane, ML_TS);
    for (int u = blockIdx.x; u < ML_NC * ML_H; u += F.G) { const int c = u >> 2, hh = u & 3; const int tok0 = c * ML_L;
        if (w == 0) { float b0, b1, cs0, cs1, G, cm; ml_chunk_scalars(gates, c, hh, lane, b0, b1, cs0, cs1, G, cm);
            const float mc = mst[u]; float inc = fmaxf(cs0, cs1);
#pragma unroll
            for (int o = 1; o < 64; o <<= 1) { const float t = __shfl_up(inc, o); if (lane >= o) inc = fmaxf(inc, t); }
            float ex = __shfl_up(inc, 1); if (lane == 0) ex = -3.0e38f;
            const float M0 = fmaxf(mc, fmaxf(ex, cs0)), M1 = fmaxf(mc, inc);
            sM[2 * lane] = M0; sM[2 * lane + 1] = M1; sCS[2 * lane] = cs0; sCS[2 * lane + 1] = cs1;
            sWI[2 * lane] = __expf(mc - M0); sWI[2 * lane + 1] = __expf(mc - M1); sEM[2 * lane] = __expf(-(b0 + M0)); sEM[2 * lane + 1] = __expf(-(b1 + M1)); }
        if (tid >= 64 && tid < 64 + ML_DK) sNV[tid - 64] = nst[(size_t)u * ML_DK + (tid - 64)];
        ml_load_tile<128>(T0 + (size_t)tok0 * D + hh * ML_DK, D, qt, ML_TS, tid);
        ml_load_tile<128>(T0 + (size_t)tok0 * D + 512 + hh * ML_DK, D, kt, ML_TS, tid);
        __syncthreads();
        int qn_l = qn; asm volatile("" : "+v"(qn_l));
        const int t = 32 * tb + qn; const float Mt = sM[t]; float rowsum = 0.f; v2u pp[2][4];
#pragma unroll
        for (int i = 0; i < 2; ++i) { const int st = 2 * wh + i;
#pragma unroll
            for (int g = 0; g < 4; ++g) pp[i][g] = (v2u){0u, 0u};
            if (st <= tb) { f32x16 a = {};
#pragma unroll
                for (int ks = 0; ks < 8; ++ks) a = MFMA32(frag_row(kt, ML_TS, 32 * st, 16 * ks, lane), frag_row(qt, ML_TS, 32 * tb, 16 * ks, lane), a);
#pragma unroll
                for (int r = 0; r < 16; ++r) a[r] *= __expf(sCS[32 * st + crow(r, hi)] - Mt);
                if (st == tb) {
#pragma unroll
                    for (int r = 0; r < 16; ++r) if (crow(r, hi) > qn_l) a[r] = 0.f; }
                rowsum += sum16(a);
#pragma unroll
                for (int g = 0; g < 4; ++g) pp[i][g] = (v2u){pk2(a[4 * g], a[4 * g + 1]), pk2(a[4 * g + 2], a[4 * g + 3])}; } }
        rowsum = hsum(rowsum);
        if (hi == 0) sDS[wh * 128 + t] = rowsum;
        __syncthreads();
        { LAS unsigned char* P = kt;
#pragma unroll
          for (int i = 0; i < 2; ++i)
#pragma unroll
              for (int g = 0; g < 4; ++g) *(LAS v2u*)(P + t * ML_TS + (32 * (2 * wh + i) + 8 * g + 4 * hi) * 2) = pp[i][g]; }
        { float s = 0.f; const int tq = tid & 127, dq = (tid >> 7) * 32; const LAS bf16* qr = (const LAS bf16*)(qt + tq * ML_TS) + dq;
#pragma unroll 8
            for (int d = 0; d < 32; ++d) s += __builtin_bit_cast(float, (unsigned)qr[d] << 16) * sNV[dq + d];
            sQP[tid] = s; }
        __syncthreads();
        { const int row = tid >> 2, seg = tid & 3; const float wi = sWI[row]; LAS v4u* p = (LAS v4u*)(qt + row * ML_TS + seg * 64);
#pragma unroll
          for (int i = 0; i < 4; ++i) { const v4u x = p[i]; v4u y; y.x = pk2(bf_lo(x.x) * wi, bf_hi(x.x) * wi); y.y = pk2(bf_lo(x.y) * wi, bf_hi(x.y) * wi); y.z = pk2(bf_lo(x.z) * wi, bf_hi(x.z) * wi); y.w = pk2(bf_lo(x.w) * wi, bf_hi(x.w) * wi); p[i] = y; } }
        f32x16 num[2][2];
#pragma unroll
        for (int hf = 0; hf < 2; ++hf) {
            if (hf) __syncthreads();
            ml_load_tile<128>(T1 + (size_t)tok0 * D + hh * ML_DV + 128 * hf, D, vt, ML_TS, tid);
            ml_load_tile<128>(Ct + (size_t)u * 32768 + (size_t)(128 * hf) * ML_DK, ML_DK, ct, ML_TS, tid);
            __syncthreads();
            num[hf][0] = (f32x16){}; num[hf][1] = (f32x16){};
            for (int ks = 0; ks < 2 * (tb + 1); ++ks) { const bf16x8 b = frag_row(kt, ML_TS, 32 * tb, 16 * ks, lane);
#pragma unroll
                for (int i = 0; i < 2; ++i) num[hf][i] = MFMA32(frag_tr_nat(vt, ML_TS, 16 * ks, 32 * (2 * wh + i), lane, trv), b, num[hf][i]); }
#pragma unroll
            for (int ks = 0; ks < 8; ++ks) { const bf16x8 b = frag_row(qt, ML_TS, 32 * tb, 16 * ks, lane);
#pragma unroll
                for (int i = 0; i < 2; ++i) num[hf][i] = MFMA32(frag_row(ct, ML_TS, 32 * (2 * wh + i), 16 * ks, lane), b, num[hf][i]); }
        }
        float den = sDS[t] + sDS[128 + t] + sWI[t] * ((sQP[t] + sQP[128 + t]) + (sQP[256 + t] + sQP[384 + t])); den = fmaxf(fabsf(den), sEM[t]); const float inv = 1.0f / den; float sq = 0.f;
#pragma unroll
        for (int hf = 0; hf < 2; ++hf)
#pragma unroll
            for (int i = 0; i < 2; ++i)
#pragma unroll
                for (int r = 0; r < 16; ++r) { num[hf][i][r] *= inv; sq += num[hf][i][r] * num[hf][i][r]; }
        sq = hsum(sq);
        if (hi == 0) sSQ[wh * 128 + t] = sq;
        __syncthreads();
        const float rinv = 1.0f / sqrtf((sSQ[t] + sSQ[128 + t]) * (1.0f / ML_DV) + EPS);
#pragma unroll
        for (int hf = 0; hf < 2; ++hf)
#pragma unroll
            for (int i = 0; i < 2; ++i)
#pragma unroll
                for (int g = 0; g < 4; ++g) { const int col = hh * ML_DV + 128 * hf + 32 * (2 * wh + i) + 8 * g + 4 * hi; bf16* op = T2 + (size_t)(tok0 + t) * D + col;
                    const v2u ow = *(const v2u*)op; const f32x4 hg = *(const f32x4*)(hgain + col);
                    const float o0 = bf_lo(ow.x), o1 = bf_hi(ow.x), o2 = bf_lo(ow.y), o3 = bf_hi(ow.y);
                    const float y0 = num[hf][i][4 * g] * rinv * hg[0] * __builtin_amdgcn_rcpf(1.0f + __expf(-o0)), y1 = num[hf][i][4 * g + 1] * rinv * hg[1] * __builtin_amdgcn_rcpf(1.0f + __expf(-o1));
                    const float y2 = num[hf][i][4 * g + 2] * rinv * hg[2] * __builtin_amdgcn_rcpf(1.0f + __expf(-o2)), y3 = num[hf][i][4 * g + 3] * rinv * hg[3] * __builtin_amdgcn_rcpf(1.0f + __expf(-o3));
                    *(v2u*)op = (v2u){pk2(y0, y1), pk2(y2, y3)}; }
        __syncthreads();
    }
}

constexpr int KT_S = 144, VT_S = 192;
constexpr int MB_VT_OFF = 256 * KT_S;
__device__ __forceinline__ bf16* po_slot(Frame& F, int slot) { return (slot < 2) ? (bf16*)F.out + (size_t)slot * S * D : WSP(bf16, WS_PO2); }
__device__ __forceinline__ int list_base(int h, int j) { return h * LIST_HEAD_CAP + 256 * (63 * j - (j * (j - 1)) / 2); }
__device__ __forceinline__ void mb_load_kv(const bf16* Kg, const bf16* Vg, int j, int h, LAS unsigned char* lds, int tid) {
    const int row = tid >> 1, half = tid & 1; const size_t go = (size_t)(j * MB_BLK + row) * D + h * DH + half * 32;
    const v4u* ks = (const v4u*)(Kg + go); const v4u* vs = (const v4u*)(Vg + go);
    LAS v4u* kd = (LAS v4u*)(lds + row * KT_S + half * 64); LAS v4u* vd = (LAS v4u*)(lds + MB_VT_OFF + row * VT_S + half * 64);
#pragma unroll
    for (int i = 0; i < 4; ++i) { kd[i] = ks[i]; vd[i] = vs[i]; }
}
constexpr float MB_THR = 6.0f;
template <bool CAUSAL> __device__ __forceinline__ void mb_attend(LAS const unsigned char* kt, LAS const unsigned char* vt, const bf16x8 (&qf)[4], int nkb, int lane, f32x16& o0, f32x16& o1, float& m, float& lsum) {
    const int hi = lane >> 5, qn = lane & 31, trv = tr_lane_off(lane, VT_S);
    o0 = (f32x16){}; o1 = (f32x16){}; m = -1.0e30f; lsum = 0.f;
    bf16x8 kf[4];
#pragma unroll
    for (int s = 0; s < 4; ++s) kf[s] = frag_row(kt, KT_S, 0, 16 * s, lane);
    for (int kb = 0; kb < nkb; ++kb) {
        f32x16 st = {}, st2 = {};
        st = MFMA32(kf[0], qf[0], st); st2 = MFMA32(kf[1], qf[1], st2); st = MFMA32(kf[2], qf[2], st); st2 = MFMA32(kf[3], qf[3], st2);
        const int kn = (kb + 1 < nkb) ? kb + 1 : kb;
#pragma unroll
        for (int s = 0; s < 4; ++s) kf[s] = frag_row(kt, KT_S, 32 * kn, 16 * s, lane);
        const bf16x8 v00 = frag_tr_acc(vt, VT_S, 32 * kb, 0, lane, trv), v01 = frag_tr_acc(vt, VT_S, 32 * kb, 32, lane, trv), v10 = frag_tr_acc(vt, VT_S, 32 * kb + 16, 0, lane, trv), v11 = frag_tr_acc(vt, VT_S, 32 * kb + 16, 32, lane, trv);
        __builtin_amdgcn_sched_barrier(0);
        st += st2;
        if (CAUSAL) { if (kb == nkb - 1) {
#pragma unroll
            for (int r = 0; r < 16; ++r) if (crow(r, hi) > qn) st[r] = -1.0e30f; } }
        const float mb = hmax(max16(st));
        if (__any(mb > m + MB_THR)) { const float mn = fmaxf(m, mb), alpha = ex2(m - mn); m = mn; lsum *= alpha; o0 *= alpha; o1 *= alpha; }
#pragma unroll
        for (int r = 0; r < 16; ++r) st[r] = ex2(st[r] - m);
        lsum += sum16(st);
        const bf16x8 p0 = pack_acc(st, 0), p1 = pack_acc(st, 1);
        o0 = MFMA32(v00, p0, o0); o1 = MFMA32(v01, p0, o1); o0 = MFMA32(v10, p1, o0); o1 = MFMA32(v11, p1, o1);
    }
}
struct MbTile { f32x16 o0, o1; float m, l; };
__device__ __forceinline__ void mb_softmax_step(f32x16& st, MbTile& T) {
    const float mb = hmax(max16(st));
    if (__any(mb > T.m + MB_THR)) { const float mn = fmaxf(T.m, mb), alpha = ex2(T.m - mn); T.m = mn; T.l *= alpha; T.o0 *= alpha; T.o1 *= alpha; }
#pragma unroll
    for (int r = 0; r < 16; ++r) st[r] = ex2(st[r] - T.m);
    T.l += sum16(st);
}
__device__ __forceinline__ void mb_attend2(LAS const unsigned char* kt, LAS const unsigned char* vt, const bf16x8 (&qa)[4], const bf16x8 (&qb)[4], int nkb, int lane, MbTile& A, MbTile& B) {
    const int trv = tr_lane_off(lane, VT_S);
    A.o0 = (f32x16){}; A.o1 = (f32x16){}; A.m = -1.0e30f; A.l = 0.f; B.o0 = (f32x16){}; B.o1 = (f32x16){}; B.m = -1.0e30f; B.l = 0.f;
    bf16x8 kf[4];
#pragma unroll
    for (int s = 0; s < 4; ++s) kf[s] = frag_row(kt, KT_S, 0, 16 * s, lane);
    f32x16 sa0 = {}, sb0 = {}, sa1 = {}, sb1 = {};
#pragma unroll
    for (int s = 0; s < 4; ++s) { sa0 = MFMA32(kf[s], qa[s], sa0); sb0 = MFMA32(kf[s], qb[s], sb0); }
#define MB2_STEP(CA, CB, NA, NB, KB) do { \
        const bf16x8 v00 = frag_tr_acc(vt, VT_S, 32 * (KB), 0, lane, trv), v01 = frag_tr_acc(vt, VT_S, 32 * (KB), 32, lane, trv), v10 = frag_tr_acc(vt, VT_S, 32 * (KB) + 16, 0, lane, trv), v11 = frag_tr_acc(vt, VT_S, 32 * (KB) + 16, 32, lane, trv); \
        if ((KB) + 1 < nkb) { NA = (f32x16){}; NB = (f32x16){}; \
            _Pragma("unroll") for (int s = 0; s < 4; ++s) { const bf16x8 kf_ = frag_row(kt, KT_S, 32 * ((KB) + 1), 16 * s, lane); NA = MFMA32(kf_, qa[s], NA); NB = MFMA32(kf_, qb[s], NB); } } \
        mb_softmax_step(CA, A); mb_softmax_step(CB, B); \
        const bf16x8 pa0 = pack_acc(CA, 0), pb0 = pack_acc(CB, 0), pa1 = pack_acc(CA, 1), pb1 = pack_acc(CB, 1); \
        A.o0 = MFMA32(v00, pa0, A.o0); B.o0 = MFMA32(v00, pb0, B.o0); A.o1 = MFMA32(v01, pa0, A.o1); B.o1 = MFMA32(v01, pb0, B.o1); \
        A.o0 = MFMA32(v10, pa1, A.o0); B.o0 = MFMA32(v10, pb1, B.o0); A.o1 = MFMA32(v11, pa1, A.o1); B.o1 = MFMA32(v11, pb1, B.o1); } while (0)
    int kb = 0;
    for (; kb + 1 < nkb; kb += 2) { MB2_STEP(sa0, sb0, sa1, sb1, kb); MB2_STEP(sa1, sb1, sa0, sb0, kb + 1); }
    if (kb < nkb) MB2_STEP(sa0, sb0, sa1, sb1, kb);
#undef MB2_STEP
}
__device__ __forceinline__ void mb_store_partial(Frame& F, float* lse, const MbTile& T, bool valid, int q, int slot, int h, int hi) {
    const float ls = hsum(T.l), inv = 1.0f / ls;
    if (valid) { bf16* op = po_slot(F, slot) + (size_t)q * D + h * DH + 4 * hi;
#pragma unroll
        for (int g = 0; g < 4; ++g) { *(v2u*)(op + 8 * g) = (v2u){pk2(T.o0[4 * g] * inv, T.o0[4 * g + 1] * inv), pk2(T.o0[4 * g + 2] * inv, T.o0[4 * g + 3] * inv)};
                                      *(v2u*)(op + 32 + 8 * g) = (v2u){pk2(T.o1[4 * g] * inv, T.o1[4 * g + 1] * inv), pk2(T.o1[4 * g + 2] * inv, T.o1[4 * g + 3] * inv)}; }
        if (hi == 0) lse[((size_t)q * NHEAD + h) * 4 + slot] = T.m + lg2(ls); }
}
__device__ __forceinline__ void top3_insert(float g, int j, float& v0, float& v1, float& v2, int& i0, int& i1, int& i2) {
    const bool b0 = (g > v0) || (g == v0 && j < i0), b1 = (g > v1) || (g == v1 && j < i1), b2 = (g > v2) || (g == v2 && j < i2);
    const float n2 = b1 ? v1 : (b2 ? g : v2), n1 = b0 ? v0 : (b1 ? g : v1), n0 = b0 ? g : v0;
    const int m2 = b1 ? i1 : (b2 ? j : i2), m1 = b0 ? i0 : (b1 ? j : i1), m0 = b0 ? j : i0;
    v0 = n0; v1 = n1; v2 = n2; i0 = m0; i1 = m1; i2 = m2;
}
__device__ __forceinline__ void route_tile(const bf16* Qg, float* lse, LAS const unsigned char* kh, LAS const unsigned char* kl, LAS int* cntl, int tbase, int h, int cur, int lane, unsigned& sel, unsigned& rk01, unsigned& rk2) {
    const int hi = lane >> 5, qn = lane & 31, t = tbase + qn; const bf16* qp = Qg + (size_t)t * D + h * DH + 8 * hi; bf16x8 qf[4];
#pragma unroll
    for (int s = 0; s < 4; ++s) qf[s] = *(const bf16x8*)(qp + 16 * s);
    float v0 = -3.0e38f, v1 = -3.0e38f, v2 = -3.0e38f; int i0 = 255, i1 = 255, i2 = 255;
#pragma unroll
    for (int jt = 0; jt < 2; ++jt) if (32 * jt < cur) { f32x16 g = {};
#pragma unroll
        for (int s = 0; s < 4; ++s) { g = MFMA32(frag_row(kh, KT_S, 32 * jt, 16 * s, lane), qf[s], g); g = MFMA32(frag_row(kl, KT_S, 32 * jt, 16 * s, lane), qf[s], g); }
#pragma unroll
        for (int r = 0; r < 16; ++r) { const int j = 32 * jt + crow(r, hi); top3_insert((j < cur) ? g[r] : -3.0e38f, (j < cur) ? j : 255, v0, v1, v2, i0, i1, i2); } }
    { const float p0 = __shfl_xor(v0, 32), p1 = __shfl_xor(v1, 32), p2 = __shfl_xor(v2, 32); const int q0 = __shfl_xor(i0, 32), q1 = __shfl_xor(i1, 32), q2 = __shfl_xor(i2, 32);
      top3_insert(p0, q0, v0, v1, v2, i0, i1, i2); top3_insert(p1, q1, v0, v1, v2, i0, i1, i2); top3_insert(p2, q2, v0, v1, v2, i0, i1, i2); }
    int r0 = 0, r1 = 0, r2 = 0;
    if (hi == 0) { if (i0 != 255) r0 = __hip_atomic_fetch_add(cntl + i0, 1, __ATOMIC_RELAXED, __HIP_MEMORY_SCOPE_WORKGROUP);
                   if (i1 != 255) r1 = __hip_atomic_fetch_add(cntl + i1, 1, __ATOMIC_RELAXED, __HIP_MEMORY_SCOPE_WORKGROUP);
                   if (i2 != 255) r2 = __hip_atomic_fetch_add(cntl + i2, 1, __ATOMIC_RELAXED, __HIP_MEMORY_SCOPE_WORKGROUP);
                   *(f32x4*)(lse + ((size_t)t * NHEAD + h) * 4) = (f32x4){-1.0e30f, -1.0e30f, -1.0e30f, -1.0e30f}; }
    sel = (unsigned)i0 | ((unsigned)i1 << 8) | ((unsigned)i2 << 16); rk01 = (unsigned)r0 | ((unsigned)r1 << 16); rk2 = (unsigned)r2;
}
__device__ __forceinline__ void route_emit(unsigned short* list, LAS const int* basel, int h, int t, unsigned sel, unsigned rk01, unsigned rk2) {
    const int i0 = sel & 255u, i1 = (sel >> 8) & 255u, i2 = (sel >> 16) & 255u;
    if (i0 != 255) list[(size_t)list_base(h, i0) + basel[i0] + (int)(rk01 & 0xffffu)] = (unsigned short)(t | (0 << 14));
    if (i1 != 255) list[(size_t)list_base(h, i1) + basel[i1] + (int)(rk01 >> 16)] = (unsigned short)(t | (1 << 14));
    if (i2 != 255) list[(size_t)list_base(h, i2) + basel[i2] + (int)rk2] = (unsigned short)(t | (2 << 14));
}
__device__ __forceinline__ void moba_route(Frame& F) {
    const bf16* Qg = WSP(bf16, WS_T0); const float* km = WSP(float, WS_KMEAN); unsigned short* list = WSP(unsigned short, WS_LIST); int* cnt = WSP(int, WS_CNT); float* lse = WSP(float, WS_LSE);
    LAS unsigned char* kh = F.lds; LAS unsigned char* kl = F.lds + 9216;
    LAS int* cntl = (LAS int*)(F.lds + 18432); LAS int* basel = cntl + 64;
    const int tid = F.tid, lane = F.lane, w = F.wave, hi = lane >> 5, qn = lane & 31;
    for (int u = blockIdx.x, k = 0; u < NHEAD * (S / 512); u += F.G, ++k) { const int h = u >> 5, t0 = ((k & 1) ? 31 - (u & 31) : (u & 31)) * 512;
        __syncthreads();
        { const int j = tid >> 3, d8 = (tid & 7) * 8; const f32x4* src = (const f32x4*)(km + ((size_t)h * 64 + j) * 64 + d8); const f32x4 a = src[0], b = src[1]; float x[8] = {a[0], a[1], a[2], a[3], b[0], b[1], b[2], b[3]}; unsigned hw[4], lw[4];
#pragma unroll
          for (int i = 0; i < 4; ++i) { hw[i] = pk2(x[2 * i], x[2 * i + 1]); lw[i] = pk2(x[2 * i] - bf_lo(hw[i]), x[2 * i + 1] - bf_hi(hw[i])); }
          *(LAS v4u*)(kh + j * KT_S + d8 * 2) = (v4u){hw[0], hw[1], hw[2], hw[3]}; *(LAS v4u*)(kl + j * KT_S + d8 * 2) = (v4u){lw[0], lw[1], lw[2], lw[3]}; }
        if (tid < 64) cntl[tid] = 0;
        __syncthreads();
        const int cur = __builtin_amdgcn_readfirstlane((t0 + 64 * w) >> 8);
        unsigned selA, selB, rkA0, rkA1, rkB0, rkB1;
        route_tile(Qg, lse, kh, kl, cntl, t0 + 64 * w, h, cur, lane, selA, rkA0, rkA1);
        route_tile(Qg, lse, kh, kl, cntl, t0 + 64 * w + 32, h, cur, lane, selB, rkB0, rkB1);
        __syncthreads();
        if (tid < 64) { const int c = cntl[tid]; basel[tid] = (c > 0) ? __hip_atomic_fetch_add(cnt + h * 64 + tid, c, __ATOMIC_RELAXED, __HIP_MEMORY_SCOPE_AGENT) : 0; }
        __syncthreads();
        if (hi == 0) { route_emit(list, basel, h, t0 + 64 * w + qn, selA, rkA0, rkA1); route_emit(list, basel, h, t0 + 64 * w + 32 + qn, selB, rkB0, rkB1); }
    }
}
struct MbSeg { int b, ta, tb; };
__device__ __forceinline__ bool mb_next_seg(LAS const int* pre, LAS const int* cnt, int c0, int c1, int bfrom, MbSeg& sg) {
    constexpr int LC = 22;
    for (int b = bfrom; b < 1024 && pre[b] < c1; ++b) { const int nt = (cnt[b] + 31) >> 5; if (nt == 0) continue;
        const int ta = max(0, c0 - pre[b] - LC), tb = min(nt, c1 - pre[b] - LC); if (tb > ta) { sg.b = b; sg.ta = ta; sg.tb = tb; return true; } }
    return false;
}
__device__ __forceinline__ void mb_kv_request(const bf16* Kg, const bf16* Vg, int j, int h, int tid, v4u (&kr)[4], v4u (&vr)[4]) {
    const int row = tid >> 1, half = tid & 1; const size_t go = (size_t)(j * MB_BLK + row) * D + h * DH + half * 32; const v4u* ks = (const v4u*)(Kg + go); const v4u* vs = (const v4u*)(Vg + go);
#pragma unroll
    for (int i = 0; i < 4; ++i) { kr[i] = ks[i]; vr[i] = vs[i]; }
}
__device__ __forceinline__ void mb_kv_commit(LAS unsigned char* lds, int tid, const v4u (&kr)[4], const v4u (&vr)[4]) {
    const int row = tid >> 1, half = tid & 1; LAS v4u* kd = (LAS v4u*)(lds + row * KT_S + half * 64); LAS v4u* vd = (LAS v4u*)(lds + MB_VT_OFF + row * VT_S + half * 64);
#pragma unroll
    for (int i = 0; i < 4; ++i) { kd[i] = kr[i]; vd[i] = vr[i]; }
}
struct MbEnt { unsigned ea, eb; };
__device__ __forceinline__ MbEnt mb_entries(const unsigned short* list, size_t lb, int tp, int tb, int n, int qn) {
    const int ia = 32 * tp + qn, ib = ia + 32; const bool va = ia < n, vb = (tp + 1 < tb) && (ib < n); MbEnt e;
    e.ea = (unsigned)list[lb + (va ? ia : 32 * tp)] | (va ? 0u : 0x80000000u); e.eb = (unsigned)list[lb + (vb ? ib : 32 * tp)] | (vb ? 0u : 0x80000000u); return e;
}
__device__ __forceinline__ void mb_qfrags(const bf16* Qg, const MbEnt& e, int h, int hi, bf16x8 (&qa)[4], bf16x8 (&qb)[4]) {
    const bf16* pa = Qg + (size_t)(e.ea & 0x3fffu) * D + h * DH + 8 * hi; const bf16* pb = Qg + (size_t)(e.eb & 0x3fffu) * D + h * DH + 8 * hi;
#pragma unroll
    for (int s = 0; s < 4; ++s) { qa[s] = *(const bf16x8*)(pa + 16 * s); qb[s] = *(const bf16x8*)(pb + 16 * s); }
}
__device__ __forceinline__ void moba_selected(Frame& F) {
    const bf16* Qg = WSP(bf16, WS_T0); const bf16* Kg = WSP(bf16, WS_T1); const bf16* Vg = WSP(bf16, WS_T2);
    const unsigned short* list = WSP(unsigned short, WS_LIST); const int* cnt = WSP(int, WS_CNT); float* lse = WSP(float, WS_LSE);
    LAS int* pre = (LAS int*)(F.lds + 98304);
    const int tid = F.tid, lane = F.lane, w = F.wave, hi = lane >> 5, qn = lane & 31;
    constexpr int LC = 22;
    LAS int* cntl = pre + 1088;
    { if (w == 0) { int loc[16]; int s = 0;
#pragma unroll
            for (int i = 0; i < 16; ++i) { const int c = cnt[lane * 16 + i]; cntl[lane * 16 + i] = c; const int nt = (c + 31) >> 5; loc[i] = nt ? nt + LC : 0; s += loc[i]; }
            int inc = s;
#pragma unroll
            for (int o = 1; o < 64; o <<= 1) { const int t = __shfl_up(inc, o); if (lane >= o) inc += t; }
            int run = inc - s;
#pragma unroll
            for (int i = 0; i < 16; ++i) { pre[lane * 16 + i] = run; run += loc[i]; }
            if (lane == 63) pre[1024] = run; }
        __syncthreads(); }
    const int ctot = pre[1024], share = (ctot + F.G - 1) / F.G, c0 = blockIdx.x * share, c1 = min(ctot, c0 + share);
    MbSeg sg; bool have_seg = false;
    if (c0 < c1) { int lo = 0, hb_ = 1024; while (hb_ - lo > 1) { const int mid = (lo + hb_) >> 1; if (pre[mid] <= c0) lo = mid; else hb_ = mid; }
        have_seg = mb_next_seg(pre, cntl, c0, c1, lo, sg); }
    while (have_seg) {
        const int h = sg.b >> 6, j = sg.b & 63, n = cntl[sg.b], tb = sg.tb; const size_t lb = (size_t)list_base(h, j);
        MbSeg nsg; const bool have_next = mb_next_seg(pre, cntl, c0, c1, sg.b + 1, nsg);
        int tp = sg.ta + 2 * w; MbEnt e0 = {0u, 0u}, e1 = {0u, 0u};
        if (tp < tb) e0 = mb_entries(list, lb, tp, tb, n, qn);
        if (tp + 2 * NWAVES < tb) e1 = mb_entries(list, lb, tp + 2 * NWAVES, tb, n, qn);
        __syncthreads();
        mb_load_kv(Kg, Vg, j, h, F.lds, tid);
        __syncthreads();
        while (tp < tb) {
            const int tp1 = tp + 2 * NWAVES, tp2 = tp + 4 * NWAVES; MbEnt e2 = {0u, 0u};
            if (tp2 < tb) e2 = mb_entries(list, lb, tp2, tb, n, qn);
            bf16x8 qa[4], qb[4]; mb_qfrags(Qg, e0, h, hi, qa, qb);
            MbTile A, B;
            mb_attend2(F.lds, F.lds + MB_VT_OFF, qa, qb, 8, lane, A, B);
            mb_store_partial(F, lse, A, !(e0.ea >> 31), e0.ea & 0x3fffu, (e0.ea >> 14) & 3u, h, hi); mb_store_partial(F, lse, B, !(e0.eb >> 31), e0.eb & 0x3fffu, (e0.eb >> 14) & 3u, h, hi);
            e0 = e1; e1 = e2; tp = tp1;
        }
        sg = nsg; have_seg = have_next;
    }
    __syncthreads();
}
__device__ __forceinline__ void moba_own_merge(Frame& F) {
    bf16* Qg = WSP(bf16, WS_T0); const bf16* Kg = WSP(bf16, WS_T1); const bf16* Vg = WSP(bf16, WS_T2); const float* lse = WSP(float, WS_LSE);
    const int tid = F.tid, lane = F.lane, w = F.wave, hi = lane >> 5, qn = lane & 31;
    int u = blockIdx.x; v4u kr[4], vr[4]; bf16x8 qn_[4];
    if (u < NHEAD * MB_NB) { mb_kv_request(Kg, Vg, u >> 4, u & 15, tid, kr, vr); const bf16* qp = Qg + (size_t)((u >> 4) * MB_BLK + 32 * w + qn) * D + (u & 15) * DH + 8 * hi;
#pragma unroll
        for (int s = 0; s < 4; ++s) qn_[s] = *(const bf16x8*)(qp + 16 * s); }
    for (; u < NHEAD * MB_NB; u += F.G) { const int h = u & 15, j = u >> 4; const int un = u + F.G;
        __syncthreads();
        mb_kv_commit(F.lds, tid, kr, vr);
        bf16x8 qf[4];
#pragma unroll
        for (int s = 0; s < 4; ++s) qf[s] = qn_[s];
        __syncthreads();
        if (un < NHEAD * MB_NB) { mb_kv_request(Kg, Vg, un >> 4, un & 15, tid, kr, vr); const bf16* qp = Qg + (size_t)((un >> 4) * MB_BLK + 32 * w + qn) * D + (un & 15) * DH + 8 * hi;
#pragma unroll
            for (int s = 0; s < 4; ++s) qn_[s] = *(const bf16x8*)(qp + 16 * s); }
        const int t = j * MB_BLK + 32 * w + qn; bf16* qp = Qg + (size_t)t * D + h * DH;
        const f32x4 lw = *(const f32x4*)(lse + ((size_t)t * NHEAD + h) * 4);
        v2u pr[3][8];
#pragma unroll
        for (int s = 0; s < 3; ++s) { const bool on = lw[s] > -1.0e29f; const bf16* pp = po_slot(F, s) + (size_t)t * D + h * DH + 4 * hi;
#pragma unroll
            for (int g = 0; g < 4; ++g) { pr[s][g] = on ? *(const v2u*)(pp + 8 * g) : (v2u){0u, 0u}; pr[s][4 + g] = on ? *(const v2u*)(pp + 32 + 8 * g) : (v2u){0u, 0u}; } }
        f32x16 o0, o1; float m, ls;
        mb_attend<true>(F.lds, F.lds + MB_VT_OFF, qf, w + 1, lane, o0, o1, m, ls);
        ls = hsum(ls);
        const float lown = m + lg2(ls);
        const float W = fmaxf(fmaxf(lown, lw[0]), fmaxf(lw[1], lw[2]));
        const float cown = ex2(lown - W); float cs[3];
#pragma unroll
        for (int s = 0; s < 3; ++s) cs[s] = (lw[s] > -1.0e29f) ? ex2(lw[s] - W) : 0.f;
        const float rden = 1.0f / (cown + cs[0] + cs[1] + cs[2]); const float co = cown * rden / ls;
        o0 *= co; o1 *= co;
#pragma unroll
        for (int s = 0; s < 3; ++s) { const float c_ = cs[s] * rden;
#pragma unroll
            for (int g = 0; g < 4; ++g) { const v2u a = pr[s][g], b = pr[s][4 + g];
                o0[4 * g] += c_ * bf_lo(a.x); o0[4 * g + 1] += c_ * bf_hi(a.x); o0[4 * g + 2] += c_ * bf_lo(a.y); o0[4 * g + 3] += c_ * bf_hi(a.y);
                o1[4 * g] += c_ * bf_lo(b.x); o1[4 * g + 1] += c_ * bf_hi(b.x); o1[4 * g + 2] += c_ * bf_lo(b.y); o1[4 * g + 3] += c_ * bf_hi(b.y); } }
#pragma unroll
        for (int g = 0; g < 4; ++g) { *(v2u*)(qp + 4 * hi + 8 * g) = (v2u){pk2(o0[4 * g], o0[4 * g + 1]), pk2(o0[4 * g + 2], o0[4 * g + 3])};
                                      *(v2u*)(qp + 4 * hi + 32 + 8 * g) = (v2u){pk2(o1[4 * g], o1[4 * g + 1]), pk2(o1[4 * g + 2], o1[4 * g + 3])}; }
    }
    __syncthreads();
}

__device__ __forceinline__ void up8(const v4u x, float (&o)[8]) { o[0] = bf_lo(x.x); o[1] = bf_hi(x.x); o[2] = bf_lo(x.y); o[3] = bf_hi(x.y); o[4] = bf_lo(x.z); o[5] = bf_hi(x.z); o[6] = bf_lo(x.w); o[7] = bf_hi(x.w); }
__device__ __forceinline__ void ld8(const bf16* p, float (&o)[8]) { const v4u x = *(const v4u*)p; o[0] = bf_lo(x.x); o[1] = bf_hi(x.x); o[2] = bf_lo(x.y); o[3] = bf_hi(x.y); o[4] = bf_lo(x.z); o[5] = bf_hi(x.z); o[6] = bf_lo(x.w); o[7] = bf_hi(x.w); }
__device__ __forceinline__ void conv_phase(Frame& F) {
    bf16* Bg = WSP(bf16, WS_T0); const bf16* Zg = WSP(bf16, WS_T1); const float* cw = F.in[10];
    const int tid = F.tid, cg = tid & 127, rp = tid >> 7;
    float w0[8], w1[8], w2[8];
#pragma unroll
    for (int e = 0; e < 8; ++e) { w0[e] = cw[cg * 8 + e]; w1[e] = cw[D + cg * 8 + e]; w2[e] = cw[2 * D + cg * 8 + e]; }
    for (int u = blockIdx.x; u < S / 64; u += F.G) { const int r0 = u * 64 + rp * 16; float zm2[8], zm1[8];
        if (r0 >= 2) { ld8(Zg + (size_t)(r0 - 2) * D + cg * 8, zm2); ld8(Zg + (size_t)(r0 - 1) * D + cg * 8, zm1); }
        else {
#pragma unroll
            for (int e = 0; e < 8; ++e) { zm2[e] = 0.f; zm1[e] = 0.f; } }
        for (int rb = r0; rb < r0 + 16; rb += 8) { v4u zz[8], bb[8];
#pragma unroll
            for (int i = 0; i < 8; ++i) { zz[i] = *(const v4u*)(Zg + (size_t)(rb + i) * D + cg * 8); bb[i] = *(const v4u*)(Bg + (size_t)(rb + i) * D + cg * 8); }
#pragma unroll
            for (int i = 0; i < 8; ++i) { float z[8], b[8], y[8]; up8(zz[i], z); up8(bb[i], b);
#pragma unroll
                for (int e = 0; e < 8; ++e) { y[e] = b[e] * (w0[e] * zm2[e] + w1[e] * zm1[e] + w2[e] * z[e]); zm2[e] = zm1[e]; zm1[e] = z[e]; }
                *(v4u*)(Bg + (size_t)(rb + i) * D + cg * 8) = (v4u){pk2(y[0], y[1]), pk2(y[2], y[3]), pk2(y[4], y[5]), pk2(y[6], y[7])}; } }
    }
}

constexpr float SB_STOP = 64.0f;
__device__ __forceinline__ void sb_load(const bf16* Kg, const bf16* Vg, int kb, int head, int lane, bf16x8 (&k)[4], v4u (&v)[4]) {
    const bf16* kp = Kg + (size_t)(kb * 32 + (lane & 31)) * D + head * DH + 8 * (lane >> 5); const v4u* vs = (const v4u*)(Vg + (size_t)(kb * 32 + (lane >> 1)) * D + head * DH + 32 * (lane & 1));
#pragma unroll
    for (int s = 0; s < 4; ++s) { k[s] = *(const bf16x8*)(kp + 16 * s); v[s] = vs[s]; }
}
__device__ __forceinline__ bool sb_block(const bf16x8 (&kf)[4], const v4u (&vv)[4], const bf16x8 (&qf)[4], LAS unsigned char* vt, bool diag, int lane, int trv, f32x16& o0, f32x16& o1, float& R) {
    const int hi = lane >> 5, qn = lane & 31;
    { LAS v4u* vd = (LAS v4u*)(vt + (lane >> 1) * VT_S + (lane & 1) * 64);
#pragma unroll
      for (int i = 0; i < 4; ++i) vd[i] = vv[i]; }
    f32x16 st = {};
#pragma unroll
    for (int s = 0; s < 4; ++s) st = MFMA32(kf[s], qf[s], st);
    float sp[16];
#pragma unroll
    for (int r = 0; r < 16; ++r) { st[r] = fminf(st[r], 100.f); sp[r] = lg2(1.0f + ex2(st[r])); }
    if (diag) {
#pragma unroll
        for (int r = 0; r < 16; ++r) if (crow(r, hi) >= qn) sp[r] = 0.f; }
    float ina[16], gt[4];
#pragma unroll
    for (int g = 0; g < 4; ++g) { const float s3 = sp[4 * g + 3], s2 = sp[4 * g + 2] + s3, s1 = sp[4 * g + 1] + s2, s0 = sp[4 * g] + s1;
        ina[4 * g + 3] = 0.f; ina[4 * g + 2] = s3; ina[4 * g + 1] = s2; ina[4 * g] = s1; gt[g] = s0; }
    float tail = 0.f, later[4];
#pragma unroll
    for (int g = 3; g >= 0; --g) { float lo_, hi_; halves(gt[g], lo_, hi_); later[g] = hi ? tail : (hi_ + tail); tail += lo_ + hi_; }
#pragma unroll
    for (int r = 0; r < 16; ++r) st[r] = ex2(st[r] - sp[r] - (R + later[r >> 2] + ina[r]));
    if (diag) {
#pragma unroll
        for (int r = 0; r < 16; ++r) if (crow(r, hi) >= qn) st[r] = 0.f; }
    R += tail;
#pragma unroll
    for (int s2 = 0; s2 < 2; ++s2) { const bf16x8 pf = pack_acc(st, s2);
        o0 = MFMA32(frag_tr_acc(vt, VT_S, 16 * s2, 0, lane, trv), pf, o0);
        o1 = MFMA32(frag_tr_acc(vt, VT_S, 16 * s2, 32, lane, trv), pf, o1); }
    return __all(R > SB_STOP);
}
__device__ __forceinline__ void sb_phase(Frame& F) {
    bf16* Qg = WSP(bf16, WS_T0); const bf16* Kg = WSP(bf16, WS_T1); const bf16* Vg = WSP(bf16, WS_T2);
    const int lane = F.lane, hi = lane >> 5, qn = lane & 31;
    LAS unsigned char* vt = F.lds + AUX_OFF + F.wave * 6144;
    const int trv = tr_lane_off(lane, VT_S);
    for (int u = blockIdx.x * NWAVES + F.wave; u < NHEAD * (S / 32); u += F.G * NWAVES) { const int head = u & 15, qb = u >> 4, t = qb * 32 + qn;
        bf16* qp = Qg + (size_t)t * D + head * DH; bf16x8 qf[4];
#pragma unroll
        for (int s = 0; s < 4; ++s) qf[s] = *(const bf16x8*)(qp + 8 * hi + 16 * s);
        f32x16 o0 = {}, o1 = {}; float R = 0.f;
        bf16x8 kA[4], kB[4], kC[4]; v4u vA[4], vB[4], vC[4]; int kb = qb;
        sb_load(Kg, Vg, kb, head, lane, kA, vA); sb_load(Kg, Vg, kb > 0 ? kb - 1 : 0, head, lane, kB, vB);
        for (;;) {
            sb_load(Kg, Vg, kb > 1 ? kb - 2 : 0, head, lane, kC, vC);
            if (sb_block(kA, vA, qf, vt, kb == qb, lane, trv, o0, o1, R) || kb == 0) break; --kb;
            sb_load(Kg, Vg, kb > 1 ? kb - 2 : 0, head, lane, kA, vA);
            if (sb_block(kB, vB, qf, vt, false, lane, trv, o0, o1, R) || kb == 0) break; --kb;
            sb_load(Kg, Vg, kb > 1 ? kb - 2 : 0, head, lane, kB, vB);
            if (sb_block(kC, vC, qf, vt, false, lane, trv, o0, o1, R) || kb == 0) break; --kb;
        }
#pragma unroll
        for (int g = 0; g < 4; ++g) { *(v2u*)(qp + 4 * hi + 8 * g) = (v2u){pk2(o0[4 * g], o0[4 * g + 1]), pk2(o0[4 * g + 2], o0[4 * g + 3])};
                                      *(v2u*)(qp + 4 * hi + 32 + 8 * g) = (v2u){pk2(o1[4 * g], o1[4 * g + 1]), pk2(o1[4 * g + 2], o1[4 * g + 3])}; }
    }
}

__device__ __forceinline__ void final_norm(Frame& F) {
    const bf16* hb = WSP(bf16, WS_HB); float* out = F.out; const float* ss = WSP(float, WS_SS); const float* fg = F.in[17];
    const int gw = blockIdx.x * NWAVES + F.wave, NGW = F.G * NWAVES, lane = F.lane;
    for (int row = gw; row < S; row += NGW) { const float rs = pg8::row_rs(ss, row); const v2u* hr = (const v2u*)(hb + (size_t)row * D) + lane; f32x4* orow = (f32x4*)(out + (size_t)row * D) + lane;
#pragma unroll
        for (int j = 0; j < 4; ++j) { const v2u x = hr[64 * j]; const f32x4 g = *((const f32x4*)fg + lane + 64 * j);
            orow[64 * j] = (f32x4){bf_lo(x.x) * rs * g[0], bf_hi(x.x) * rs * g[1], bf_lo(x.y) * rs * g[2], bf_hi(x.y) * rs * g[3]}; } }
}
__device__ __forceinline__ void rs_preamble(Frame& F, const pg8::StaticOrder& So, const float* ss) {
    LAS float* rsl = (LAS float*)(F.lds + RSL_OFF); pg8::Unit u;
    for (int i = 0; So.next(i, u); ++i) { if (F.tid < 256) rsl[i * 256 + F.tid] = pg8::row_rs(ss, u.pm * 256 + F.tid); }
    __syncthreads();
}

struct Args { const float* in[18]; float* out; unsigned char* ws; int ph_lo, ph_hi; };
__global__ void __launch_bounds__(NWAVES * 64, 2) hybrid_fwd(Args args) {
    extern __shared__ __attribute__((aligned(16))) unsigned char lds[];
    Frame F;
    F.lds = (LAS unsigned char*)lds;
    F.MISC = (volatile LAS unsigned*)(F.lds + MISC_OFF);
    F.tid = threadIdx.x; F.lane = F.tid & 63; F.wave = __builtin_amdgcn_readfirstlane(F.tid >> 6);
    F.G = gridDim.x; F.ws = args.ws; F.out = args.out;
#pragma unroll
    for (int i = 0; i < 18; ++i) F.in[i] = args.in[i];
    F.ctl = (gu32*)(args.ws + WS_CTL);
    for (int u = F.tid; u < (LDS_BYTES - MISC_OFF) / 4; u += NWAVES * 64) ((LAS unsigned*)(F.lds + MISC_OFF))[u] = 0u;
    __syncthreads();
    XcdBarrier bar; bar.bar = (unsigned*)(F.ctl + CW_BAR); bar.x = 0; bar.st = nullptr;
    if (!MK_PER_PHASE) bar = xcd_barrier_post((unsigned*)(F.ctl + CW_BAR), F.MISC + 8);
    const int lo = args.ph_lo, hi = args.ph_hi;
#define IN(k) (lo <= (k) && (k) < hi)
    const bool pr_on = (PROBE_MASK != 0u) && blockIdx.x == PROBE_BLOCK && F.tid == 0;
    volatile LAS unsigned long long* const prs = (volatile LAS unsigned long long*)(F.lds + MISC_OFF + 64);
    if (pr_on) { prs[0] = __builtin_amdgcn_s_memrealtime(); prs[1] = 0ull; }
#define PSTAMP(k) do { if (pr_on) { const unsigned long long t_ = __builtin_amdgcn_s_memrealtime(); if (!PROBE_PRE && ((PROBE_MASK >> (k)) & 1u)) prs[1] = prs[1] + (t_ - prs[0]); prs[0] = t_; } } while (0)
#define PSTAMP_PRE(k) do { if (PROBE_PRE && pr_on) { const unsigned long long t_ = __builtin_amdgcn_s_memrealtime(); if ((PROBE_MASK >> (k)) & 1u) prs[1] = prs[1] + (t_ - prs[0]); prs[0] = t_; } } while (0)
#define SEAM(k) do { PSTAMP_PRE(k); if (IN(k) && IN((k) + 1)) xcd_barrier(bar); PSTAMP(k); } while (0)
    bf16* const T0 = WSP(bf16, WS_T0); bf16* const T2 = WSP(bf16, WS_T2); bf16* const HB = WSP(bf16, WS_HB); float* const SS = WSP(float, WS_SS); const float* const ROPE = WSP(float, WS_ROPE);
    bf16* const WIN = WSP(bf16, WS_WIN); bf16* const WOUT = WSP(bf16, WS_WOUT);
    LAS unsigned char* const ring = F.lds;
#define GEMM_IN(MODE, NSC, SC0) do { pg8::Gemm g{HB, WIN, S, 3 * D, D}; pg8::StaticOrder So; So.init(S, 3 * D, F.G, (int)blockIdx.x); rs_preamble(F, So, SS); \
        pg8::EpiIn<MODE> E{T0, (const LAS float*)(F.lds + RSL_OFF), ROPE, (NSC), (SC0), WSP(float, WS_KMEAN)}; pg8::gemm_phase<pg8::EpiIn<MODE>, pg8::StaticOrder, true, true>(ring, g, So, E); } while (0)
#define GEMM_OUT(APTR, RESF32) do { pg8::Gemm g{(APTR), WOUT, S, D, D}; pg8::StaticOrder So; So.init(S, D, F.G, (int)blockIdx.x); \
        pg8::EpiRes<RESF32> E{F.in[0], HB, SS}; pg8::gemm_phase<pg8::EpiRes<RESF32>, pg8::StaticOrder, false, true>(ring, g, So, E); } while (0)
#define GEMM_UP(L) do { pg8::Gemm g{HB, ((L) & 1) ? WSP(bf16, WS_WGU1) : WSP(bf16, WS_WGU), S, 2 * FF, D}; pg8::StaticOrder So; So.init(S, 2 * FF, F.G, (int)blockIdx.x); rs_preamble(F, So, SS); \
        pg8::EpiGlu E{T0, FF, (const LAS float*)(F.lds + RSL_OFF)}; pg8::gemm_phase<pg8::EpiGlu, pg8::StaticOrder, true, true>(ring, g, So, E); \
        if ((L) < 3) { const int rem_ = So.nwg % F.G; convert_layer(F, (L) + 1, rem_); } } while (0)
#define GEMM_DOWN(L) do { pg8::Gemm g{T0, ((L) & 1) ? WSP(bf16, WS_WD1) : WSP(bf16, WS_WD), S, D, FF}; pg8::StaticOrder So; So.init(S, D, F.G, (int)blockIdx.x); \
        pg8::EpiRes<false> E{nullptr, HB, SS}; pg8::gemm_phase<pg8::EpiRes<false>, pg8::StaticOrder, false, true>(ring, g, So, E); } while (0)

    if (IN(0)) { if (F.wave < 4) { convert_layer(F, 0, 0); prologue_rows(F); } else { prologue_rows(F); convert_layer(F, 0, 0); } } SEAM(0);
    if (IN(1)) { GEMM_IN(0, 2, 0.08838834764831845f); } SEAM(1);
    if (IN(2)) { mlstm_phase_a(F); } SEAM(2);
    if (IN(3)) { mlstm_phase_scan(F); } SEAM(3);
    if (IN(4)) { mlstm_phase_c(F); } SEAM(4);
    if (IN(5)) { GEMM_OUT(T2, true); } SEAM(5);
    if (IN(6)) { GEMM_UP(0); } SEAM(6);
    if (IN(7)) { GEMM_DOWN(0); } SEAM(7);
    if (IN(8)) { GEMM_IN(1, 4, C2); } SEAM(8);
    if (IN(9)) { moba_route(F); } SEAM(9);
    if (IN(10)) { moba_selected(F); } SEAM(10);
    if (IN(11)) { moba_own_merge(F); } SEAM(11);
    if (IN(12)) { GEMM_OUT(T0, false); } SEAM(12);
    if (IN(13)) { GEMM_UP(1); } SEAM(13);
    if (IN(14)) { GEMM_DOWN(1); } SEAM(14);
    if (IN(15)) { GEMM_IN(2, 0, 1.0f); } SEAM(15);
    if (IN(16)) { conv_phase(F); } SEAM(16);
    if (IN(17)) { GEMM_OUT(T0, false); } SEAM(17);
    if (IN(18)) { GEMM_UP(2); } SEAM(18);
    if (IN(19)) { GEMM_DOWN(2); } SEAM(19);
    if (IN(20)) { GEMM_IN(0, 4, C2); } SEAM(20);
    if (IN(21)) { sb_phase(F); } SEAM(21);
    if (IN(22)) { GEMM_OUT(T0, false); } SEAM(22);
    if (IN(23)) { GEMM_UP(3); } SEAM(23);
    if (IN(24)) { GEMM_DOWN(3); } SEAM(24);
    if (IN(25)) { final_norm(F); } PSTAMP(25);
    if (pr_on) { const unsigned long long t0_ = __builtin_amdgcn_s_memrealtime(), span_ = (unsigned long long)PROBE_MULT * prs[1]; while (__builtin_amdgcn_s_memrealtime() - t0_ < span_) __builtin_amdgcn_s_sleep(8); }
#undef IN
#undef SEAM
}

extern "C" void kernel_launch(void* const* d_in, const int* in_sizes, int n_in, void* d_out, int out_size, void* d_ws, size_t ws_size, hipStream_t stream) {
    static int grid = 0;
    if (grid == 0) {
        if (n_in != 18 || out_size != S * D || ws_size < WS_END) { fprintf(stderr, "kernel_launch: unexpected shapes (n_in %d, out %d, ws %zu)\n", n_in, out_size, ws_size); grid = -1; return; }
        int dev = 0, cus = 0, per_cu = 0;
        if (hipGetDevice(&dev) != hipSuccess || hipDeviceGetAttribute(&cus, hipDeviceAttributeMultiprocessorCount, dev) != hipSuccess) { grid = -1; return; }
        if (hipFuncSetAttribute((const void*)hybrid_fwd, hipFuncAttributeMaxDynamicSharedMemorySize, LDS_BYTES) != hipSuccess) { fprintf(stderr, "kernel_launch: hipFuncSetAttribute failed\n"); grid = -1; return; }
        if (hipOccupancyMaxActiveBlocksPerMultiprocessor(&per_cu, (const void*)hybrid_fwd, NWAVES * 64, LDS_BYTES) != hipSuccess || per_cu < 1) { fprintf(stderr, "kernel_launch: occupancy query says %d blocks per CU\n", per_cu); }
        (void)hipGetLastError();
        grid = cus;
    }
    if (grid < 0) return;
    if (hipMemsetAsync((char*)d_ws + WS_CTL, 0, CTL_ZERO_BYTES, stream) != hipSuccess) return;
    Args a{};
    for (int i = 0; i < 18; ++i) a.in[i] = (const float*)d_in[i];
    a.out = (float*)d_out; a.ws = (unsigned char*)d_ws;
#if MK_PER_PHASE
    for (int p = 0; p < NPHASE; ++p) { a.ph_lo = p; a.ph_hi = p + 1; hipLaunchKernelGGL(hybrid_fwd, dim3(grid), dim3(NWAVES * 64), LDS_BYTES, stream, a); }
#else
    a.ph_lo = 0; a.ph_hi = NPHASE;
    hipLaunchKernelGGL(hybrid_fwd, dim3(grid), dim3(NWAVES * 64), LDS_BYTES, stream, a);
#endif
}
```
